# Optimizing an MI355X kernel written in HIP

```python
import math, functools
import jax, jax.numpy as jnp
from jax import lax
import numpy as np

D_MODEL = 2048
BATCH = 4
SEQ = 2048
DEPTH = 1
DEC_BATCH = 128
DEC_SEQ = 1
PAST_LEN = 16384
PAGE_SIZE = 128

N_META = 16
D_SSD = D_MODEL
SSD_HEADDIM = 64
SSD_HEADS = D_SSD // SSD_HEADDIM
SSD_GROUPS = 4
SSD_STATE = 128
SSD_CONV = 4
D_SC = D_MODEL
SC_CONV = 3
CHUNK = 128
EPS = 1e-5
D_GN = SSD_GROUPS * SSD_STATE
D_XBC = D_SSD + 2 * D_GN
D_MIX = D_SSD + D_SC
SPLITS = (D_SSD, D_SSD + D_XBC, D_SSD + D_XBC + SSD_HEADS,
          D_SSD + D_XBC + SSD_HEADS + D_SC, D_SSD + D_XBC + SSD_HEADS + 2 * D_SC,
          D_SSD + D_XBC + SSD_HEADS + 3 * D_SC)
D_IN_PROJ = D_SSD + D_XBC + SSD_HEADS + 4 * D_SC

kernel_name = "hymba_ssd_shortconv_step"


def rmsnorm(x, g):
    xf = x.astype(jnp.float32)
    y = xf * lax.rsqrt(jnp.mean(xf * xf, axis=-1, keepdims=True) + EPS)
    return (y * g.astype(jnp.float32)).astype(x.dtype)


def causal_dwconv(x_full, w):
    k = w.shape[0]
    t = x_full.shape[1] - k + 1
    out = x_full[:, 0:t] * w[0]
    for i in range(1, k):
        out = out + x_full[:, i:i + t] * w[i]
    return out


def ssd_chunked(x, dt, a, bm, cm):
    b, L = x.shape[0], x.shape[1]
    nc = L // CHUNK
    r = SSD_HEADS // SSD_GROUPS
    xf = x.astype(jnp.float32).reshape(b, nc, CHUNK, SSD_GROUPS, r, SSD_HEADDIM)
    dtf = dt.reshape(b, nc, CHUNK, SSD_GROUPS, r)
    bf = bm.astype(jnp.float32).reshape(b, nc, CHUNK, SSD_GROUPS, SSD_STATE)
    cf = cm.astype(jnp.float32).reshape(b, nc, CHUNK, SSD_GROUPS, SSD_STATE)
    a_cs = jnp.cumsum(dtf * a.reshape(SSD_GROUPS, r), axis=2)
    xdt = xf * dtf[..., None]
    seg = a_cs[:, :, :, None] - a_cs[:, :, None]
    causal = jnp.tril(jnp.ones((CHUNK, CHUNK), dtype=bool))[:, :, None, None]
    decay = jnp.exp(jnp.where(causal, seg, -jnp.inf))
    cb = jnp.einsum('bclgn,bcsgn->bclsg', cf, bf)
    m = cb[..., None] * decay
    y_diag = jnp.einsum('bclsgr,bcsgrp->bclgrp', m, xdt)
    decay_end = jnp.exp(a_cs[:, :, -1:] - a_cs)
    states = jnp.einsum('bclgn,bclgr,bclgrp->bcgrpn', bf, decay_end, xdt)
    chunk_decay = jnp.exp(a_cs[:, :, -1])

    def step(s, inp):
        st, dc = inp
        return s * dc[..., None, None] + st, s

    s0 = jnp.zeros((b, SSD_GROUPS, r, SSD_HEADDIM, SSD_STATE), jnp.float32)
    s_fin, s_prev = lax.scan(step, s0, (jnp.moveaxis(states, 1, 0), jnp.moveaxis(chunk_decay, 1, 0)))
    s_prev = jnp.moveaxis(s_prev, 0, 1)
    y_off = jnp.einsum('bclgn,bcgrpn,bclgr->bclgrp', cf, s_prev, jnp.exp(a_cs))
    y = (y_diag + y_off).reshape(b, L, SSD_HEADS, SSD_HEADDIM)
    return y, s_fin.reshape(b, SSD_HEADS, SSD_HEADDIM, SSD_STATE)


def ssd_recurrent(x, dt, a, bm, cm, s0):
    b = x.shape[0]
    r = SSD_HEADS // SSD_GROUPS
    ar = a.reshape(SSD_GROUPS, r)

    def step(s, inp):
        xt, dtt, bt, ct = inp
        xt = xt.astype(jnp.float32).reshape(b, SSD_GROUPS, r, SSD_HEADDIM)
        dtt = dtt.reshape(b, SSD_GROUPS, r)
        s = s * jnp.exp(dtt * ar)[..., None, None] + jnp.einsum('bgrp,bgn->bgrpn', xt * dtt[..., None], bt.astype(jnp.float32))
        yt = jnp.einsum('bgrpn,bgn->bgrp', s, ct.astype(jnp.float32))
        return s, yt.reshape(b, SSD_HEADS, SSD_HEADDIM)

    s_init = s0.astype(jnp.float32).reshape(b, SSD_GROUPS, r, SSD_HEADDIM, SSD_STATE)
    xs_t = (jnp.moveaxis(x, 1, 0), jnp.moveaxis(dt, 1, 0), jnp.moveaxis(bm, 1, 0), jnp.moveaxis(cm, 1, 0))
    s_fin, ys = lax.scan(step, s_init, xs_t)
    return jnp.moveaxis(ys, 0, 1), s_fin.reshape(b, SSD_HEADS, SSD_HEADDIM, SSD_STATE)


def _mixer_layer(u, ssd_buf, sc_buf, ssm_state, norm_w, w_in, conv_ssd_w, conv_ssd_b, dt_bias, a_log,
                 d_skip, ssd_norm_w, conv_sc_w, sc_norm_w, w_out):
    b, t = u.shape[0], u.shape[1]
    hn = rmsnorm(u, norm_w)
    z_ssd, xbc, dt_raw, z_sc, b_sc, c_sc, h_sc = jnp.split(hn @ w_in, SPLITS, axis=-1)
    xbc_full = jnp.concatenate([ssd_buf.astype(xbc.dtype), xbc], axis=1)
    xbc_c = jax.nn.silu(causal_dwconv(xbc_full, conv_ssd_w) + conv_ssd_b)
    new_ssd_buf = xbc_full[:, -(SSD_CONV - 1):]
    xs = xbc_c[..., :D_SSD].reshape(b, t, SSD_HEADS, SSD_HEADDIM)
    bm = xbc_c[..., D_SSD:D_SSD + D_GN].reshape(b, t, SSD_GROUPS, SSD_STATE)
    cm = xbc_c[..., D_SSD + D_GN:].reshape(b, t, SSD_GROUPS, SSD_STATE)
    dt = jax.nn.softplus(dt_raw.astype(jnp.float32) + dt_bias.astype(jnp.float32))
    a = -jnp.exp(a_log.astype(jnp.float32))
    if ssm_state is None:
        pad = CHUNK - N_META
        padf = lambda v: jnp.pad(v, [(0, 0), (pad, 0)] + [(0, 0)] * (v.ndim - 2))
        y, new_state = ssd_chunked(padf(xs), padf(dt), a, padf(bm), padf(cm))
        y = y[:, pad:]
    else:
        y, new_state = ssd_recurrent(xs, dt, a, bm, cm, ssm_state)
    y = y + d_skip.astype(jnp.float32)[:, None] * xs.astype(jnp.float32)
    y = y.reshape(b, t, D_SSD) * jax.nn.silu(z_ssd.astype(jnp.float32))
    y_ssd = rmsnorm(y, ssd_norm_w).astype(u.dtype)
    v = c_sc * h_sc
    v_full = jnp.concatenate([sc_buf.astype(v.dtype), v], axis=1)
    new_sc_buf = v_full[:, -(SC_CONV - 1):]
    y_sc = b_sc * causal_dwconv(v_full, conv_sc_w)
    y_sc = rmsnorm(y_sc * jax.nn.silu(z_sc), sc_norm_w)
    out = jnp.concatenate([y_ssd, y_sc], axis=-1) @ w_out
    return u + out, new_state, new_ssd_buf, new_sc_buf


def setup_inputs(seed: int = 0) -> dict:
    key = jax.random.key(seed)
    ks = jax.random.split(key, 20)
    f32 = jnp.float32
    x_prompt = jax.random.normal(ks[0], (BATCH, SEQ, D_MODEL), f32)
    x_sample = jax.random.normal(ks[1], (DEC_BATCH, DEC_SEQ, D_MODEL), f32)
    state_ssm = 0.1 * jax.random.normal(ks[2], (DEPTH, DEC_BATCH, SSD_HEADS, SSD_HEADDIM, SSD_STATE), f32)
    state_ssd_conv = jax.random.normal(ks[3], (DEPTH, DEC_BATCH, SSD_CONV - 1, D_XBC), f32)
    state_short_conv = jax.random.normal(ks[4], (DEPTH, DEC_BATCH, SC_CONV - 1, D_SC), f32)
    meta_tokens = jax.random.normal(ks[5], (N_META, D_MODEL), f32)
    norm_w = 1.0 + 0.02 * jax.random.normal(ks[6], (DEPTH, D_MODEL), f32)
    w_in = jax.random.normal(ks[7], (DEPTH, D_MODEL, D_IN_PROJ), f32) * D_MODEL ** -0.5
    conv_ssd_w = jax.random.normal(ks[8], (DEPTH, SSD_CONV, D_XBC), f32) * SSD_CONV ** -0.5
    conv_ssd_b = 0.02 * jax.random.normal(ks[9], (DEPTH, D_XBC), f32)
    dt0 = jnp.exp(jax.random.uniform(ks[10], (DEPTH, SSD_HEADS), f32) * (math.log(0.1) - math.log(0.001)) + math.log(0.001))
    dt_bias = dt0 + jnp.log(-jnp.expm1(-dt0))
    a_log = jnp.log(jax.random.uniform(ks[11], (DEPTH, SSD_HEADS), f32, 1.0, 16.0))
    d_skip = 1.0 + 0.1 * jax.random.normal(ks[12], (DEPTH, SSD_HEADS), f32)
    ssd_norm_w = 1.0 + 0.02 * jax.random.normal(ks[13], (DEPTH, D_SSD), f32)
    conv_sc_w = jax.random.normal(ks[14], (DEPTH, SC_CONV, D_SC), f32) * SC_CONV ** -0.5
    sc_norm_w = 1.0 + 0.02 * jax.random.normal(ks[15], (DEPTH, D_SC), f32)
    w_out = jax.random.normal(ks[16], (DEPTH, D_MIX, D_MODEL), f32) * D_MIX ** -0.5
    final_norm_w = 1.0 + 0.02 * jax.random.normal(ks[17], (D_MODEL,), f32)
    return {"x_prompt": x_prompt, "x_sample": x_sample, "state_ssm": state_ssm,
            "state_ssd_conv": state_ssd_conv, "state_short_conv": state_short_conv,
            "meta_tokens": meta_tokens, "norm_w": norm_w, "w_in": w_in, "conv_ssd_w": conv_ssd_w,
            "conv_ssd_b": conv_ssd_b, "dt_bias": dt_bias, "a_log": a_log, "d_skip": d_skip,
            "ssd_norm_w": ssd_norm_w, "conv_sc_w": conv_sc_w, "sc_norm_w": sc_norm_w,
            "w_out": w_out, "final_norm_w": final_norm_w}


def reference(x_prompt, x_sample, state_ssm, state_ssd_conv, state_short_conv, meta_tokens, norm_w, w_in,
              conv_ssd_w, conv_ssd_b, dt_bias, a_log, d_skip, ssd_norm_w, conv_sc_w, sc_norm_w, w_out,
              final_norm_w):
    b_p = x_prompt.shape[0]
    meta = jnp.broadcast_to(meta_tokens.astype(x_prompt.dtype)[None], (b_p, N_META, D_MODEL))
    u_p = jnp.concatenate([meta, x_prompt], axis=1)
    u_s = x_sample
    ssm_p, cssd_p, csc_p, ssm_s, cssd_s, csc_s = [], [], [], [], [], []
    for l in range(DEPTH):
        lw = (norm_w[l], w_in[l], conv_ssd_w[l], conv_ssd_b[l], dt_bias[l], a_log[l], d_skip[l],
              ssd_norm_w[l], conv_sc_w[l], sc_norm_w[l], w_out[l])
        u_p, s1, c1, k1 = _mixer_layer(u_p, jnp.zeros((b_p, SSD_CONV - 1, D_XBC), u_p.dtype),
                                       jnp.zeros((b_p, SC_CONV - 1, D_SC), u_p.dtype), None, *lw)
        u_s, s2, c2, k2 = _mixer_layer(u_s, state_ssd_conv[l], state_short_conv[l], state_ssm[l], *lw)
        ssm_p.append(s1); cssd_p.append(c1); csc_p.append(k1)
        ssm_s.append(s2); cssd_s.append(c2); csc_s.append(k2)
    y_prompt = rmsnorm(u_p, final_norm_w)[:, N_META:]
    y_sample = rmsnorm(u_s, final_norm_w)
    return (y_prompt, y_sample, jnp.stack(ssm_p), jnp.stack(cssd_p), jnp.stack(csc_p),
            jnp.stack(ssm_s), jnp.stack(cssd_s), jnp.stack(csc_s))
```

```cpp
#include <hip/hip_runtime.h>
#include <hip/hip_cooperative_groups.h>
#include <cstdio>
namespace cg = cooperative_groups;

#define LAS __attribute__((address_space(3)))
typedef unsigned short bf16_t;
typedef short bf16x8 __attribute__((ext_vector_type(8)));
typedef float f32x4 __attribute__((ext_vector_type(4)));
typedef float f32x16 __attribute__((ext_vector_type(16)));
typedef unsigned u32x4 __attribute__((ext_vector_type(4)));
typedef unsigned u32x2 __attribute__((ext_vector_type(2)));

#ifndef N_LAUNCH
#define N_LAUNCH 1
#endif

constexpr int DM = 2048;
constexpr int SEQ = 2048, NB = 4, NS = 128, NMETA = 16;
constexpr int NPROJ = 13344;
constexpr int NP = 13568;
constexpr int MP = 8448;
constexpr int BROWS = 2064;
constexpr int ROW_S0 = 8256;
constexpr int ROW_END = 8384;
constexpr int YROW_S0 = 8192;
constexpr int DXBC = 3072;
constexpr int CZ = 0, CX = 2048, CBm = 4096, CCm = 4608, CZS = 5120, CBS = 7168, CCS = 9216, CHS = 11264, CDT = 13312;
constexpr int KO = 4096;
constexpr float EPS = 1e-5f;

constexpr size_t O_YP = 0;
constexpr size_t O_YS = O_YP + (size_t)NB * SEQ * DM;
constexpr size_t O_SSMP = O_YS + (size_t)NS * DM;
constexpr size_t O_CSP = O_SSMP + (size_t)NB * 32 * 64 * 128;
constexpr size_t O_SCP = O_CSP + (size_t)NB * 3 * DXBC;
constexpr size_t O_SSMS = O_SCP + (size_t)NB * 2 * DM;
constexpr size_t O_CSS = O_SSMS + (size_t)NS * 32 * 64 * 128;
constexpr size_t O_SCS = O_CSS + (size_t)NS * 3 * DXBC;

constexpr size_t WS_WIN = 0;
constexpr size_t WS_WOUT = WS_WIN + (size_t)NP * DM * 2;
constexpr size_t WS_HN = WS_WOUT + (size_t)DM * KO * 2;
constexpr size_t WS_PROJ = WS_HN + (size_t)MP * DM * 2;
constexpr size_t WS_YMIX = WS_PROJ + (size_t)MP * NP * 2;
constexpr size_t WS_SSQ1 = WS_YMIX + (size_t)MP * KO * 2;
constexpr size_t WS_SSQ2 = WS_SSQ1 + (size_t)MP * 4;
constexpr size_t WS_SSQ3 = WS_SSQ2 + (size_t)MP * 4;
constexpr size_t WS_SSQ4 = WS_SSQ3 + (size_t)8192 * 32 * 4;
constexpr size_t WS_END = WS_SSQ4 + (size_t)128 * 128 * 4;

constexpr int LDS_BYTES = 147456;

struct Params {
    const float* x_prompt; const float* x_sample; const float* state_ssm; const float* state_ssd_conv; const float* state_short_conv;
    const float* meta; const float* norm_w; const float* w_in; const float* conv_ssd_w; const float* conv_ssd_b; const float* dt_bias;
    const float* a_log; const float* d_skip; const float* ssd_norm_w; const float* conv_sc_w; const float* sc_norm_w; const float* w_out;
    const float* final_norm_w;
    float* out; unsigned char* ws;
    int ph_lo, ph_hi;
};

__device__ __forceinline__ unsigned cvt_pk_bf16(float lo, float hi) { unsigned r; asm("v_cvt_pk_bf16_f32 %0, %1, %2" : "=v"(r) : "v"(lo), "v"(hi)); return r; }
__device__ __forceinline__ float bf_lo(unsigned u) { return __uint_as_float(u << 16); }
__device__ __forceinline__ float bf_hi(unsigned u) { return __uint_as_float(u & 0xffff0000u); }
__device__ __forceinline__ float bf1(bf16_t u) { return __uint_as_float(((unsigned)u) << 16); }
__device__ __forceinline__ float silu_f(float x) { return x / (1.0f + __expf(-x)); }
__device__ __forceinline__ float softplus_f(float x) { return x > 20.f ? x : log1pf(__expf(x)); }
__device__ __forceinline__ float wave_sum(float v) {
#pragma unroll
    for (int o = 32; o >= 1; o >>= 1) v += __shfl_xor(v, o);
    return v;
}
__device__ __forceinline__ void unpack8(const u32x4 u, float (&f)[8]) {
    f[0] = bf_lo(u.x); f[1] = bf_hi(u.x); f[2] = bf_lo(u.y); f[3] = bf_hi(u.y); f[4] = bf_lo(u.z); f[5] = bf_hi(u.z); f[6] = bf_lo(u.w); f[7] = bf_hi(u.w);
}

namespace pg8 {
constexpr int BM = 256, BK = 64, HALF = 128, HTB = HALF * BK * 2, STAGE_BYTES = 8 * HTB, NXCD = 8, WGM = 8;
__device__ __forceinline__ int lds_byte(int r, int c) { const int st = (r >> 4) * 2 + (c >> 5), rr = r & 15, cc = c & 31, ob = rr * 64 + cc * 2; return st * 1024 + (ob ^ (((ob >> 9) & 1) << 5)); }
__device__ __forceinline__ void stage_rc(int b, int& R, int& C) { const int st = b / 1024, sb = b % 1024, swz = sb ^ (((sb >> 9) & 1) << 5); R = (st >> 1) * 16 + swz / 64; C = (st & 1) * 32 + (swz % 64) / 2; }
__device__ __forceinline__ int perm32(int rho) { const int n = rho >> 4, i = rho & 15; return 8 * (i >> 2) + 4 * n + (i & 3); }
struct Unit { int pm, pn; };
struct Gemm { const bf16_t* A; const bf16_t* Bt; int M, N, K; };
struct StaticOrder {
    int nM, nN, nwg, G, c;
    __device__ void init(int M, int N, int G_, int c_) { nM = M / BM; nN = N / BM; nwg = nM * nN; G = G_; c = c_; }
    __device__ bool next(int i, Unit& u) const {
        const long L = (long)i * G + c; if (L >= nwg) return false;
        int wgid = (int)L; { const int q = nwg / NXCD, r = nwg % NXCD, xcd = wgid % NXCD, off = wgid / NXCD; wgid = (xcd < r ? xcd * (q + 1) : r * (q + 1) + (xcd - r) * q) + off; }
        const int nig = WGM * nN, gid = wgid / nig, fm = gid * WGM, gsz = (nM - fm) < WGM ? (nM - fm) : WGM;
        u.pm = fm + ((wgid % nig) % gsz); u.pn = (wgid % nig) / gsz; return true;
    }
};

struct EpiProj {
    static constexpr bool PERM = true, MID = false;
    bf16_t* O; int ldc;
    __device__ __forceinline__ void mid(f32x4 (&acc)[2][2][4][2], const Unit& u, int wr, int wc, int fr, int fq) const {}
    __device__ __forceinline__ void operator()(const f32x4 (&acc)[2][2][4][2], const Unit& u, int wr, int wc, int fr, int fq) const {
        const int row0 = u.pm * BM + wr * 64 + fr; const int col0 = u.pn * BM + wc * 32 + 8 * fq;
#pragma unroll
        for (int ai = 0; ai < 2; ++ai)
#pragma unroll
            for (int m = 0; m < 4; ++m) { bf16_t* rowp = O + (size_t)(row0 + ai * HALF + m * 16) * ldc + col0;
#pragma unroll
                for (int bj = 0; bj < 2; ++bj) { const f32x4 v0 = acc[ai][bj][m][0], v1 = acc[ai][bj][m][1];
                    u32x4 w; w.x = cvt_pk_bf16(v0[0], v0[1]); w.y = cvt_pk_bf16(v0[2], v0[3]); w.z = cvt_pk_bf16(v1[0], v1[1]); w.w = cvt_pk_bf16(v1[2], v1[3]);
                    *(u32x4*)(rowp + bj * HALF) = w; } }
    }
};
struct EpiOut {
    static constexpr bool PERM = false, MID = true;
    float* C; const float* resid; LAS const float* tab; float* part;
    __device__ __forceinline__ void mid(f32x4 (&acc)[2][2][4][2], const Unit& u, int wr, int wc, int fr, int fq) const {
#pragma unroll
        for (int ai = 0; ai < 2; ++ai)
#pragma unroll
            for (int m = 0; m < 4; ++m) { const float f = tab[wr * 64 + fr + ai * HALF + m * 16];
#pragma unroll
                for (int bj = 0; bj < 2; ++bj)
#pragma unroll
                    for (int n = 0; n < 2; ++n) acc[ai][bj][m][n] *= f;
                asm volatile("" ::: "memory"); }
    }
    __device__ __forceinline__ void operator()(const f32x4 (&acc)[2][2][4][2], const Unit& u, int wr, int wc, int fr, int fq) const {
        const int row0 = u.pm * BM + wr * 64 + fr, col0 = u.pn * BM + wc * 32 + 4 * fq;
#pragma unroll
        for (int ai = 0; ai < 2; ++ai)
#pragma unroll
            for (int m = 0; m < 4; ++m) { const int r = row0 + ai * HALF + m * 16;
                const float rs = tab[256 + wr * 64 + fr + ai * HALF + m * 16];
                const size_t off = (size_t)r * DM + col0; float ss = 0.f;
#pragma unroll
                for (int bj = 0; bj < 2; ++bj)
#pragma unroll
                    for (int n = 0; n < 2; ++n) { const f32x4 x = *(const f32x4*)(resid + off + bj * HALF + n * 16); const f32x4 v = acc[ai][bj][m][n] * rs + x;
                        *(f32x4*)(C + off + bj * HALF + n * 16) = v; ss += (v[0] * v[0] + v[1] * v[1]) + (v[2] * v[2] + v[3] * v[3]); }
                ss += __shfl_xor(ss, 16); ss += __shfl_xor(ss, 32);
                if (fq == 0) part[(size_t)r * 32 + u.pn * 4 + wc] = ss;
                asm volatile("" ::: "memory"); }
    }
};

template <class Epi>
__device__ __forceinline__ void gemm_phase(LAS unsigned char* lds, const Gemm g, const StaticOrder& S, const Epi& E) {
    const int tid = threadIdx.x, wid = __builtin_amdgcn_readfirstlane(tid >> 6), lane = tid & 63, wr = wid >> 2, wc = wid & 3, fr = lane & 15, fq = lane >> 4;
    const int K = g.K, nt = K / BK;
    unsigned voffA[2], voffB[2];
#pragma unroll
    for (int i = 0; i < 2; ++i) { int R, C; stage_rc(tid * 16 + i * 8192, R, C); const int Rb = Epi::PERM ? ((R & ~31) + perm32(R & 31)) : R;
        voffA[i] = (unsigned)(R * K + C) * 2u; voffB[i] = (unsigned)(Rb * K + C) * 2u; }
    const size_t kstep = (size_t)(BK * 2);
    const size_t hstep = (size_t)HALF * K * 2;
    const size_t tstep = 2 * hstep;
    const unsigned ldsw = (unsigned)wid * 1024u;
    const int aoff = lds_byte(wr * 64 + fr, fq * 8), boff = lds_byte(wc * 32 + fr, fq * 8);
#define PG8_SA(b, h) (((b) * 2 + (h)) * HTB)
#define PG8_SB(b, h) ((4 + (b) * 2 + (h)) * HTB)
#define PG8_STAGE(bufoff, gbase, voff) do { _Pragma("unroll") for (int _i = 0; _i < 2; ++_i) \
        __builtin_amdgcn_global_load_lds((const unsigned*)((const char*)(gbase) + (voff)[_i]), (LAS unsigned*)(lds + (bufoff) + ldsw + _i * 8192), 16, 0, 0); } while (0)
#define PG8_LDA(dst, b, h) do { _Pragma("unroll") for (int m = 0; m < 4; ++m) _Pragma("unroll") for (int k = 0; k < 2; ++k) dst[m][k] = *(const LAS bf16x8*)(lds + PG8_SA(b, h) + aoff + m * 2048 + k * 1024); } while (0)
#define PG8_LDB(dst, b, h) do { _Pragma("unroll") for (int n = 0; n < 2; ++n) _Pragma("unroll") for (int k = 0; k < 2; ++k) dst[n][k] = *(const LAS bf16x8*)(lds + PG8_SB(b, h) + boff + n * 2048 + k * 1024); } while (0)
#define PG8_MMA(ai, bj, At, Bt) do { __builtin_amdgcn_s_setprio(1); _Pragma("unroll") for (int m = 0; m < 4; ++m) _Pragma("unroll") for (int n = 0; n < 2; ++n) _Pragma("unroll") for (int k = 0; k < 2; ++k) \
        acc[ai][bj][m][n] = __builtin_amdgcn_mfma_f32_16x16x32_bf16(Bt[n][k], At[m][k], acc[ai][bj][m][n], 0, 0, 0); __builtin_amdgcn_s_setprio(0); } while (0)
#define PG8_WAIT_V(n) asm volatile("s_waitcnt vmcnt(" #n ")" ::: "memory")
#define PG8_WAIT_L(n) asm volatile("s_waitcnt lgkmcnt(" #n ")" ::: "memory")
#define PG8_BAR __builtin_amdgcn_s_barrier()
#define PG8_SCHED __builtin_amdgcn_sched_barrier(0)
    Unit cur, nxt; int ui = 0;
    if (!S.next(0, cur)) return;
    f32x4 acc[2][2][4][2];
#pragma unroll
    for (int a = 0; a < 2; ++a)
#pragma unroll
        for (int b = 0; b < 2; ++b)
#pragma unroll
            for (int m = 0; m < 4; ++m)
#pragma unroll
                for (int n = 0; n < 2; ++n) acc[a][b][m][n] = (f32x4){0.f, 0.f, 0.f, 0.f};
    bf16x8 At[4][2], B0[2][2], B1[2][2];
    const char* cA = (const char*)g.A + (size_t)cur.pm * tstep; const char* cB = (const char*)g.Bt + (size_t)cur.pn * tstep;
    PG8_STAGE(PG8_SB(0, 0), cB, voffB); PG8_STAGE(PG8_SA(0, 0), cA, voffA); PG8_STAGE(PG8_SB(0, 1), cB + hstep, voffB); PG8_STAGE(PG8_SA(0, 1), cA + hstep, voffA);
    if (wr == 1) PG8_BAR;
    PG8_WAIT_V(4); PG8_BAR;
    PG8_STAGE(PG8_SB(1, 0), cB + kstep, voffB); PG8_STAGE(PG8_SA(1, 0), cA + kstep, voffA); PG8_STAGE(PG8_SB(1, 1), cB + hstep + kstep, voffB);
    PG8_WAIT_V(6); PG8_BAR;
    for (;;) {
        const bool has_next = S.next(ui + 1, nxt);
        const char* nA = has_next ? (const char*)g.A + (size_t)nxt.pm * tstep : cA; const char* nB = has_next ? (const char*)g.Bt + (size_t)nxt.pn * tstep : cB;
        for (int t = 0; t < nt; t += 2) {
            const bool last = (t == nt - 2);
            const char* a1 = cA + (size_t)(t + 1) * kstep;
            const char* a2 = last ? nA : cA + (size_t)(t + 2) * kstep; const char* b2 = last ? nB : cB + (size_t)(t + 2) * kstep;
            const char* a3 = a2 + kstep; const char* b3 = b2 + kstep;
            if constexpr (Epi::MID) { if (t == (nt >> 1)) E.mid(acc, cur, wr, wc, fr, fq); }
            PG8_LDB(B0, 0, 0); PG8_SCHED; PG8_LDA(At, 0, 0); PG8_STAGE(PG8_SA(1, 1), a1 + hstep, voffA);
            PG8_WAIT_L(8); PG8_BAR; PG8_WAIT_L(0); PG8_MMA(0, 0, At, B0); PG8_BAR; PG8_SCHED;
            PG8_LDB(B1, 0, 1); PG8_STAGE(PG8_SB(0, 0), b2, voffB);
            PG8_BAR; PG8_WAIT_L(0); PG8_MMA(0, 1, At, B1); PG8_BAR;
            PG8_LDA(At, 0, 1); PG8_STAGE(PG8_SA(0, 0), a2, voffA);
            PG8_BAR; PG8_WAIT_L(0); PG8_MMA(1, 0, At, B0); PG8_BAR; PG8_SCHED;
            PG8_STAGE(PG8_SB(0, 1), b2 + hstep, voffB);
            PG8_WAIT_V(6); PG8_BAR; PG8_MMA(1, 1, At, B1); PG8_BAR;
            PG8_LDB(B0, 1, 0); PG8_SCHED; PG8_LDA(At, 1, 0); PG8_STAGE(PG8_SA(0, 1), a2 + hstep, voffA);
            PG8_WAIT_L(8); PG8_BAR; PG8_WAIT_L(0); PG8_MMA(0, 0, At, B0); PG8_BAR; PG8_SCHED;
            PG8_LDB(B1, 1, 1); PG8_STAGE(PG8_SB(1, 0), b3, voffB);
            PG8_BAR; PG8_WAIT_L(0); PG8_MMA(0, 1, At, B1); PG8_BAR;
            PG8_LDA(At, 1, 1); PG8_STAGE(PG8_SA(1, 0), a3, voffA);
            PG8_BAR; PG8_WAIT_L(0); PG8_MMA(1, 0, At, B0); PG8_BAR; PG8_SCHED;
            PG8_STAGE(PG8_SB(1, 1), b3 + hstep, voffB);
            PG8_WAIT_V(6); PG8_BAR; PG8_MMA(1, 1, At, B1); PG8_BAR;
        }
        E(acc, cur, wr, wc, fr, fq);
        if (!has_next) break;
#pragma unroll
        for (int a = 0; a < 2; ++a)
#pragma unroll
            for (int b = 0; b < 2; ++b)
#pragma unroll
                for (int m = 0; m < 4; ++m)
#pragma unroll
                    for (int n = 0; n < 2; ++n) acc[a][b][m][n] = (f32x4){0.f, 0.f, 0.f, 0.f};
        cur = nxt; cA = nA; cB = nB; ++ui;
    }
    PG8_WAIT_V(0);
    if (wr == 0) PG8_BAR;
    PG8_BAR;
#undef PG8_SA
#undef PG8_SB
#undef PG8_STAGE
#undef PG8_LDA
#undef PG8_LDB
#undef PG8_MMA
#undef PG8_WAIT_V
#undef PG8_WAIT_L
#undef PG8_BAR
#undef PG8_SCHED
}
}

__device__ __forceinline__ void tr_tile(LAS unsigned char* lds, const float* __restrict__ src, int spitch, int scol0, int nvalid, int k0,
                                        bf16_t* __restrict__ dst, int dpitch, int n0, const float* __restrict__ sc0, const float* __restrict__ sc1) {
    const int tid = threadIdx.x;
    LAS unsigned* T = (LAS unsigned*)lds;
    const int nq = tid & 15, kp = tid >> 4;
#pragma unroll
    for (int pass = 0; pass < 2; ++pass) {
        const int kk = pass * 64 + kp * 2;
        const int kg = k0 + kk;
        f32x4 r0 = (f32x4){0.f, 0.f, 0.f, 0.f}, r1 = r0;
        if (nq * 4 < nvalid) {
            r0 = *(const f32x4*)(src + (size_t)kg * spitch + scol0 + nq * 4);
            r1 = *(const f32x4*)(src + (size_t)(kg + 1) * spitch + scol0 + nq * 4);
        }
        float s0 = 1.f, s1 = 1.f;
        if (sc0) { s0 = (kg < 2048) ? sc0[kg] : sc1[kg - 2048]; s1 = (kg + 1 < 2048) ? sc0[kg + 1] : sc1[kg + 1 - 2048]; }
#pragma unroll
        for (int j = 0; j < 4; ++j) T[(nq * 4 + j) * 68 + (kk >> 1)] = cvt_pk_bf16(r0[j] * s0, r1[j] * s1);
    }
    __syncthreads();
#pragma unroll
    for (int i = 0; i < 2; ++i) {
        const int ch = tid + i * 512; const int n = ch >> 4, c16 = ch & 15;
        const u32x4 v = *(const LAS u32x4*)(T + n * 68 + c16 * 4);
        *(u32x4*)(dst + (size_t)(n0 + n) * dpitch + k0 + c16 * 8) = v;
    }
    __syncthreads();
}

__device__ void p0_prep(const Params& p, LAS unsigned char* lds) {
    const int tid = threadIdx.x, lane = tid & 63, wid = tid >> 6;
    bf16_t* WinT = (bf16_t*)(p.ws + WS_WIN); bf16_t* WoutT = (bf16_t*)(p.ws + WS_WOUT); bf16_t* hn = (bf16_t*)(p.ws + WS_HN);
    { float* s1 = (float*)(p.ws + WS_SSQ1); for (int i = blockIdx.x * 512 + tid; i < 2 * MP; i += gridDim.x * 512) s1[i] = 0.f; }
    constexpr int T_IN = 212 * 16, T_OUT = 32 * 32;
    for (int t = blockIdx.x; t < T_IN + T_OUT; t += gridDim.x) {
        if (t < T_IN) {
            const int nt_ = t >> 4, kt = t & 15; const int n0 = nt_ * 64;
            int scol, nvalid;
            if (n0 < 5120) { scol = n0; nvalid = 64; }
            else if (n0 < 13312) { scol = n0 + 32; nvalid = 64; }
            else if (n0 == 13312) { scol = 5120; nvalid = 32; }
            else { scol = 0; nvalid = 0; }
            tr_tile(lds, p.w_in, NPROJ, scol, nvalid, kt * 128, WinT, DM, n0, nullptr, nullptr);
        } else {
            const int tt = t - T_IN; const int nt_ = tt >> 5, kt = tt & 31;
            tr_tile(lds, p.w_out, DM, nt_ * 64, 64, kt * 128, WoutT, KO, nt_ * 64, p.ssd_norm_w, p.sc_norm_w);
        }
    }
    const int gw = blockIdx.x * 8 + wid, nw = gridDim.x * 8;
    for (int r = gw; r < MP; r += nw) {
        bf16_t* o = hn + (size_t)r * DM;
        if (r >= ROW_END) {
#pragma unroll
            for (int i = 0; i < 8; ++i) *(u32x2*)(o + i * 256 + lane * 4) = (u32x2){0u, 0u};
            continue;
        }
        const float* src;
        if (r < ROW_S0) { const int bb = r / BROWS, q = r - bb * BROWS; src = q < NMETA ? p.meta + (size_t)q * DM : p.x_prompt + ((size_t)bb * SEQ + (q - NMETA)) * DM; }
        else src = p.x_sample + (size_t)(r - ROW_S0) * DM;
        f32x4 v[8]; float ss = 0.f;
#pragma unroll
        for (int i = 0; i < 8; ++i) { v[i] = *(const f32x4*)(src + i * 256 + lane * 4); ss += (v[i][0] * v[i][0] + v[i][1] * v[i][1]) + (v[i][2] * v[i][2] + v[i][3] * v[i][3]); }
        ss = wave_sum(ss);
        const float rs = __builtin_amdgcn_rsqf(ss * (1.0f / 2048.f) + EPS);
#pragma unroll
        for (int i = 0; i < 8; ++i) { const f32x4 w = *(const f32x4*)(p.norm_w + i * 256 + lane * 4);
            u32x2 pk; pk.x = cvt_pk_bf16(v[i][0] * rs * w[0], v[i][1] * rs * w[1]); pk.y = cvt_pk_bf16(v[i][2] * rs * w[2], v[i][3] * rs * w[3]);
            *(u32x2*)(o + i * 256 + lane * 4) = pk; }
    }
}

constexpr int PIT = 272;
constexpr int L_CS = 0, L_BS = 34816, L_BT = 69632, L_XT = 104448, L_SB = 121856, L_SC = 139264;
constexpr int F_DT = 0, F_ACS = 256, F_WV = 512, F_SSL = 768, F_AEND = 1024;

__device__ __forceinline__ void ssd_scan(const Params& p, LAS float* sm, int buf, int rb, int lmin, int h, float dtb, float a_neg) {
    const int lane = threadIdx.x & 63;
    const bf16_t* proj = (const bf16_t*)(p.ws + WS_PROJ);
    float d0 = 0.f, d1 = 0.f;
    { const int l0 = 2 * lane, g0 = max(rb + l0, 0), g1 = max(rb + l0 + 1, 0);
      d0 = softplus_f(bf1(proj[(size_t)g0 * NP + CDT + h]) + dtb); d1 = softplus_f(bf1(proj[(size_t)g1 * NP + CDT + h]) + dtb);
      d0 = l0 >= lmin ? d0 : 0.f; d1 = l0 + 1 >= lmin ? d1 : 0.f; }
    const float x0 = d0 * a_neg, x1 = d1 * a_neg;
    float s = x0 + x1;
#pragma unroll
    for (int o = 1; o < 64; o <<= 1) { const float t = __shfl_up(s, o); if (lane >= o) s += t; }
    const float c1 = s, c0 = s - x1;
    const float aend = __shfl(s, 63);
    sm[F_DT + buf * 128 + 2 * lane] = d0; sm[F_DT + buf * 128 + 2 * lane + 1] = d1;
    sm[F_ACS + buf * 128 + 2 * lane] = c0; sm[F_ACS + buf * 128 + 2 * lane + 1] = c1;
    sm[F_WV + buf * 128 + 2 * lane] = d0 * __expf(aend - c0); sm[F_WV + buf * 128 + 2 * lane + 1] = d1 * __expf(aend - c1);
    if (lane == 0) sm[F_AEND + buf] = aend;
}

template <int NR, class Store>
__device__ __forceinline__ void conv_rows(const Params& p, int rb, int lmin, int l0, int pcol, int wcol, Store&& st) {
    const bf16_t* proj = (const bf16_t*)(p.ws + WS_PROJ);
    u32x4 raw[NR + 3];
#pragma unroll
    for (int i = 0; i < NR + 3; ++i) { const int l = l0 - 3 + i; const int g = max(rb + l, 0);
        raw[i] = *(const u32x4*)(proj + (size_t)g * NP + pcol);
        if (l < lmin) raw[i] = (u32x4){0u, 0u, 0u, 0u}; }
    float w[4][8], bias[8];
#pragma unroll
    for (int k = 0; k < 4; ++k) { const f32x4 a = *(const f32x4*)(p.conv_ssd_w + k * DXBC + wcol), b = *(const f32x4*)(p.conv_ssd_w + k * DXBC + wcol + 4);
        w[k][0] = a[0]; w[k][1] = a[1]; w[k][2] = a[2]; w[k][3] = a[3]; w[k][4] = b[0]; w[k][5] = b[1]; w[k][6] = b[2]; w[k][7] = b[3]; }
    { const f32x4 a = *(const f32x4*)(p.conv_ssd_b + wcol), b = *(const f32x4*)(p.conv_ssd_b + wcol + 4);
      bias[0] = a[0]; bias[1] = a[1]; bias[2] = a[2]; bias[3] = a[3]; bias[4] = b[0]; bias[5] = b[1]; bias[6] = b[2]; bias[7] = b[3]; }
    float h0[8], h1[8], h2[8], cur[8];
    unpack8(raw[0], h0); unpack8(raw[1], h1); unpack8(raw[2], h2);
#pragma unroll
    for (int i = 0; i < NR; ++i) {
        unpack8(raw[i + 3], cur);
        const bool valid = (l0 + i) >= lmin;
        float o[8];
#pragma unroll
        for (int j = 0; j < 8; ++j) { const float a = bias[j] + w[0][j] * h0[j] + w[1][j] * h1[j] + w[2][j] * h2[j] + w[3][j] * cur[j]; o[j] = valid ? silu_f(a) : 0.f; }
        st(i, o);
#pragma unroll
        for (int j = 0; j < 8; ++j) { h0[j] = h1[j]; h1[j] = h2[j]; h2[j] = cur[j]; }
    }
}

__device__ void ssd_item(const Params& p, LAS unsigned char* lds, int item) {
    const int tid = threadIdx.x, lane = tid & 63, w = __builtin_amdgcn_readfirstlane(tid >> 6), r = lane & 31, hh = lane >> 5;
    const int pair = (item & 7) + 8 * (item >> 6), hg = (item >> 3) & 7;
    const int b = pair >> 2, g = pair & 3, h = g * 8 + hg;
    const bf16_t* proj = (const bf16_t*)(p.ws + WS_PROJ);
    bf16_t* ymix = (bf16_t*)(p.ws + WS_YMIX);
    float* ssq1 = (float*)(p.ws + WS_SSQ1);
    LAS float* sm = (LAS float*)(lds + L_SC);
    const float dtb = p.dt_bias[h], a_neg = -__expf(p.a_log[h]), Dh = p.d_skip[h];
    for (int i = tid; i < 17408 / 4; i += 512) ((LAS unsigned*)(lds + L_SB))[i] = 0u;
    if (w == 1) ssd_scan(p, sm, 0, b * BROWS - 112, 112, h, dtb, a_neg);
    f32x16 accS;
#pragma unroll
    for (int i = 0; i < 16; ++i) accS[i] = 0.f;
    const int lt = w >> 1, pt = w & 1, pt2 = w >> 2, nt = w & 3;
    __syncthreads();
    for (int c = 0; c <= 16; ++c) {
        const int buf = c & 1; const int rb = b * BROWS + NMETA + (c - 1) * 128, lmin = (c == 0) ? 112 : -3; const int base = b * SEQ + (c - 1) * 128;
        {
            const int rseg = tid >> 4; const int l0 = rseg * 4; const int n0 = (tid & 15) * 8;
            {
                const int xcol = 2048 + g * 128 + n0;
                unsigned bt[8][2];
                conv_rows<4>(p, rb, lmin, l0, CX + xcol, xcol, [&](int i, const float (&o)[8]) {
                    u32x4 pk; pk.x = cvt_pk_bf16(o[0], o[1]); pk.y = cvt_pk_bf16(o[2], o[3]); pk.z = cvt_pk_bf16(o[4], o[5]); pk.w = cvt_pk_bf16(o[6], o[7]);
                    *(LAS u32x4*)(lds + L_BS + (l0 + i) * PIT + n0 * 2) = pk;
                    const float wl = sm[F_WV + buf * 128 + l0 + i];
#pragma unroll
                    for (int j = 0; j < 8; ++j) { const unsigned q = cvt_pk_bf16(o[j] * wl, 0.f);
                        if (i & 1) bt[j][i >> 1] |= q << 16; else bt[j][i >> 1] = q & 0xffffu; }
                });
#pragma unroll
                for (int j = 0; j < 8; ++j) *(LAS u32x2*)(lds + L_BT + (n0 + j) * PIT + l0 * 2) = (u32x2){bt[j][0], bt[j][1]};
            }
            asm volatile("" ::: "memory");
            {
                const int xcol = 2048 + 512 + g * 128 + n0;
                conv_rows<4>(p, rb, lmin, l0, CX + xcol, xcol, [&](int i, const float (&o)[8]) {
                    u32x4 pk; pk.x = cvt_pk_bf16(o[0], o[1]); pk.y = cvt_pk_bf16(o[2], o[3]); pk.z = cvt_pk_bf16(o[4], o[5]); pk.w = cvt_pk_bf16(o[6], o[7]);
                    *(LAS u32x4*)(lds + L_CS + (l0 + i) * PIT + n0 * 2) = pk; });
            }
            asm volatile("" ::: "memory");
            const int xg = tid & 7, xs = tid >> 3; const int xl0 = xs * 2, p0 = xg * 8;
            unsigned xt[8];
            conv_rows<2>(p, rb, lmin, xl0, CX + h * 64 + p0, h * 64 + p0, [&](int i, const float (&o)[8]) {
#pragma unroll
                for (int j = 0; j < 8; ++j) { const unsigned q = cvt_pk_bf16(o[j], 0.f); if (i & 1) xt[j] |= q << 16; else xt[j] = q & 0xffffu; } });
#pragma unroll
            for (int j = 0; j < 8; ++j) *(LAS unsigned*)(lds + L_XT + (p0 + j) * PIT + xl0 * 2) = xt[j];
        }
        __syncthreads();
        f32x16 cb0, cb1;
#pragma unroll
        for (int i = 0; i < 16; ++i) { cb0[i] = 0.f; cb1[i] = 0.f; }
        const int st0 = 2 * (w & 1);
        if (c > 0) {
            if (st0 <= lt) {
#pragma unroll
                for (int ks = 0; ks < 8; ++ks) {
                    const bf16x8 a = *(const LAS bf16x8*)(lds + L_CS + (lt * 32 + r) * PIT + (ks * 16 + hh * 8) * 2);
                    const bf16x8 b0 = *(const LAS bf16x8*)(lds + L_BS + (st0 * 32 + r) * PIT + (ks * 16 + hh * 8) * 2);
                    cb0 = __builtin_amdgcn_mfma_f32_32x32x16_bf16(a, b0, cb0, 0, 0, 0);
                    if (st0 + 1 <= lt) { const bf16x8 b1 = *(const LAS bf16x8*)(lds + L_BS + ((st0 + 1) * 32 + r) * PIT + (ks * 16 + hh * 8) * 2);
                        cb1 = __builtin_amdgcn_mfma_f32_32x32x16_bf16(a, b1, cb1, 0, 0, 0); }
                }
            }
        }
        if (w == 1 && c < 16) ssd_scan(p, sm, buf ^ 1, rb + 128, -3, h, dtb, a_neg);
        __syncthreads();
        if (c > 0 && st0 <= lt) {
#pragma unroll
            for (int i = 0; i < 16; ++i) { const int l = lt * 32 + (i & 3) + 8 * (i >> 2) + 4 * hh;
                *(LAS bf16_t*)(lds + L_BS + l * PIT + (st0 * 32 + r) * 2) = (bf16_t)(cvt_pk_bf16(cb0[i], 0.f) & 0xffffu);
                if (st0 + 1 <= lt) *(LAS bf16_t*)(lds + L_BS + l * PIT + ((st0 + 1) * 32 + r) * 2) = (bf16_t)(cvt_pk_bf16(cb1[i], 0.f) & 0xffffu); }
        }
        __syncthreads();
        if (c > 0) {
            f32x16 aD, aO;
#pragma unroll
            for (int i = 0; i < 16; ++i) { aD[i] = 0.f; aO[i] = 0.f; }
            const int lrow = lt * 32 + r; const float acl = sm[F_ACS + buf * 128 + lrow];
            for (int ks = 0; ks < 2 * (lt + 1); ++ks) {
                const int s0 = ks * 16 + hh * 8;
                const u32x4 craw = *(const LAS u32x4*)(lds + L_BS + lrow * PIT + s0 * 2);
                float cbv[8]; unpack8(craw, cbv);
                const f32x4 as0 = *(const LAS f32x4*)(sm + F_ACS + buf * 128 + s0), as1 = *(const LAS f32x4*)(sm + F_ACS + buf * 128 + s0 + 4);
                const f32x4 dt0 = *(const LAS f32x4*)(sm + F_DT + buf * 128 + s0), dt1 = *(const LAS f32x4*)(sm + F_DT + buf * 128 + s0 + 4);
                float mv[8];
#pragma unroll
                for (int j = 0; j < 8; ++j) { const float as = j < 4 ? as0[j & 3] : as1[j & 3]; const float dd = j < 4 ? dt0[j & 3] : dt1[j & 3];
                    mv[j] = (s0 + j <= lrow) ? cbv[j] * __expf(acl - as) * dd : 0.f; }
                u32x4 ap; ap.x = cvt_pk_bf16(mv[0], mv[1]); ap.y = cvt_pk_bf16(mv[2], mv[3]); ap.z = cvt_pk_bf16(mv[4], mv[5]); ap.w = cvt_pk_bf16(mv[6], mv[7]);
                const bf16x8 a = __builtin_bit_cast(bf16x8, ap);
                const bf16x8 bx = *(const LAS bf16x8*)(lds + L_XT + (pt * 32 + r) * PIT + s0 * 2);
                aD = __builtin_amdgcn_mfma_f32_32x32x16_bf16(a, bx, aD, 0, 0, 0);
            }
#pragma unroll
            for (int ks = 0; ks < 8; ++ks) {
                const bf16x8 a = *(const LAS bf16x8*)(lds + L_CS + lrow * PIT + (ks * 16 + hh * 8) * 2);
                const bf16x8 bs = *(const LAS bf16x8*)(lds + L_SB + (pt * 32 + r) * PIT + (ks * 16 + hh * 8) * 2);
                aO = __builtin_amdgcn_mfma_f32_32x32x16_bf16(a, bs, aO, 0, 0, 0);
            }
            const int pcol = h * 64 + pt * 32 + r;
#pragma unroll
            for (int i = 0; i < 16; ++i) {
                const int l = lt * 32 + (i & 3) + 8 * (i >> 2) + 4 * hh; const int grow = base + l;
                const float xv = bf1(*(const LAS bf16_t*)(lds + L_XT + (pt * 32 + r) * PIT + l * 2));
                const float zv = bf1(proj[(size_t)(rb + l) * NP + CZ + pcol]);
                const float y = aD[i] + __expf(sm[F_ACS + buf * 128 + l]) * aO[i] + Dh * xv;
                const float gv = y * silu_f(zv);
                ymix[(size_t)grow * KO + pcol] = (bf16_t)(cvt_pk_bf16(gv, 0.f) & 0xffffu);
                float q = gv * gv;
#pragma unroll
                for (int o = 16; o >= 1; o >>= 1) q += __shfl_xor(q, o);
                if (r == 0) sm[F_SSL + pt * 128 + l] = q;
            }
        }
        {
            const float dec = __expf(sm[F_AEND + buf]);
#pragma unroll
            for (int i = 0; i < 16; ++i) accS[i] *= dec;
#pragma unroll
            for (int ks = 0; ks < 8; ++ks) {
                const bf16x8 a = *(const LAS bf16x8*)(lds + L_XT + (pt2 * 32 + r) * PIT + (ks * 16 + hh * 8) * 2);
                const bf16x8 bb = *(const LAS bf16x8*)(lds + L_BT + (nt * 32 + r) * PIT + (ks * 16 + hh * 8) * 2);
                accS = __builtin_amdgcn_mfma_f32_32x32x16_bf16(a, bb, accS, 0, 0, 0);
            }
        }
        __syncthreads();
        if (c > 0 && tid < 128) atomicAdd(ssq1 + base + tid, sm[F_SSL + tid] + sm[F_SSL + 128 + tid]);
#pragma unroll
        for (int i = 0; i < 16; ++i) { const int pp = pt2 * 32 + (i & 3) + 8 * (i >> 2) + 4 * hh;
            *(LAS bf16_t*)(lds + L_SB + pp * PIT + (nt * 32 + r) * 2) = (bf16_t)(cvt_pk_bf16(accS[i], 0.f) & 0xffffu); }
    }
    float* so = p.out + O_SSMP + ((size_t)(b * 32 + h) * 64) * 128;
#pragma unroll
    for (int i = 0; i < 16; ++i) { const int pp = pt2 * 32 + (i & 3) + 8 * (i >> 2) + 4 * hh; so[(size_t)pp * 128 + nt * 32 + r] = accS[i]; }
    __syncthreads();
}

__device__ __forceinline__ float block_sum(float v, LAS float* red) {
    v = wave_sum(v);
    __syncthreads();
    if ((threadIdx.x & 63) == 0) red[threadIdx.x >> 6] = v;
    __syncthreads();
    float s = 0.f;
#pragma unroll
    for (int i = 0; i < 8; ++i) s += red[i];
    return s;
}

__device__ void decode_item(const Params& p, LAS unsigned char* lds, int j) {
    const int tid = threadIdx.x, lane = tid & 63, w = tid >> 6;
    const bf16_t* proj = (const bf16_t*)(p.ws + WS_PROJ);
    bf16_t* ymix = (bf16_t*)(p.ws + WS_YMIX);
    const int R = YROW_S0 + j;
    const bf16_t* prow = proj + (size_t)(ROW_S0 + j) * NP;
    LAS float* xc = (LAS float*)lds;
    LAS float* yv = xc + 3072;
    LAS float* dts = yv + 2048;
    LAS float* dAs = dts + 32;
    LAS float* red = dAs + 32;
    {
        const float* cs = p.state_ssd_conv + (size_t)j * 3 * DXBC; float* co = p.out + O_CSS + (size_t)j * 3 * DXBC;
#pragma unroll
        for (int k = 0; k < 6; ++k) { const int col = tid + 512 * k;
            const float raw = bf1(prow[CX + col]); const float s0 = cs[col], s1 = cs[DXBC + col], s2 = cs[2 * DXBC + col];
            const float a = p.conv_ssd_b[col] + p.conv_ssd_w[col] * s0 + p.conv_ssd_w[DXBC + col] * s1 + p.conv_ssd_w[2 * DXBC + col] * s2 + p.conv_ssd_w[3 * DXBC + col] * raw;
            xc[col] = silu_f(a);
            co[col] = s1; co[DXBC + col] = s2; co[2 * DXBC + col] = raw; }
        if (tid < 32) { const float d = softplus_f(bf1(prow[CDT + tid]) + p.dt_bias[tid]); dts[tid] = d; dAs[tid] = __expf(d * (-__expf(p.a_log[tid]))); }
    }
    __syncthreads();
    {
        const int g = w >> 1, q = lane & 31, half = lane >> 5;
        const f32x4 Bq = *(const LAS f32x4*)(xc + 2048 + g * 128 + 4 * q), Cq = *(const LAS f32x4*)(xc + 2560 + g * 128 + 4 * q);
        const float* sin = p.state_ssm + (size_t)j * 32 * 64 * 128; float* sout = p.out + O_SSMS + (size_t)j * 32 * 64 * 128;
        for (int hq = 0; hq < 4; ++hq) {
            const int h = 4 * w + hq; const float dtv = dts[h], dA = dAs[h], Dh = p.d_skip[h];
            for (int it0 = 0; it0 < 32; it0 += 8) {
                f32x4 sv[8];
#pragma unroll
                for (int u = 0; u < 8; ++u) { const int pp = 2 * (it0 + u) + half; sv[u] = __builtin_nontemporal_load((const f32x4*)(sin + ((size_t)h * 64 + pp) * 128 + 4 * q)); }
#pragma unroll
                for (int u = 0; u < 8; ++u) { const int pp = 2 * (it0 + u) + half; const float xv = xc[h * 64 + pp]; const float xd = xv * dtv;
                    const f32x4 sn = sv[u] * dA + Bq * xd;
                    __builtin_nontemporal_store(sn, (f32x4*)(sout + ((size_t)h * 64 + pp) * 128 + 4 * q));
                    float yp = (sn[0] * Cq[0] + sn[1] * Cq[1]) + (sn[2] * Cq[2] + sn[3] * Cq[3]);
#pragma unroll
                    for (int o = 16; o >= 1; o >>= 1) yp += __shfl_xor(yp, o);
                    if (q == 0) yv[h * 64 + pp] = yp + Dh * xv; }
            }
        }
    }
    __syncthreads();
    {
        const int c0 = tid * 4; const u32x2 zz = *(const u32x2*)(prow + CZ + c0);
        const float z[4] = {bf_lo(zz.x), bf_hi(zz.x), bf_lo(zz.y), bf_hi(zz.y)};
        float gv[4]; float ss = 0.f;
#pragma unroll
        for (int k = 0; k < 4; ++k) { gv[k] = yv[c0 + k] * silu_f(z[k]); ss += gv[k] * gv[k]; }
        const float tot = block_sum(ss, red); const float rs = __builtin_amdgcn_rsqf(tot * (1.0f / 2048.f) + EPS);
        u32x2 pk; pk.x = cvt_pk_bf16(gv[0] * rs, gv[1] * rs); pk.y = cvt_pk_bf16(gv[2] * rs, gv[3] * rs);
        *(u32x2*)(ymix + (size_t)R * KO + c0) = pk;
    }
    {
        const int c0 = tid * 4;
        const u32x2 zz = *(const u32x2*)(prow + CZS + c0), bb = *(const u32x2*)(prow + CBS + c0), cc = *(const u32x2*)(prow + CCS + c0), hh4 = *(const u32x2*)(prow + CHS + c0);
        const float z[4] = {bf_lo(zz.x), bf_hi(zz.x), bf_lo(zz.y), bf_hi(zz.y)}, bv[4] = {bf_lo(bb.x), bf_hi(bb.x), bf_lo(bb.y), bf_hi(bb.y)};
        const float cv[4] = {bf_lo(cc.x), bf_hi(cc.x), bf_lo(cc.y), bf_hi(cc.y)}, hv[4] = {bf_lo(hh4.x), bf_hi(hh4.x), bf_lo(hh4.y), bf_hi(hh4.y)};
        const float* ss_in = p.state_short_conv + (size_t)j * 2 * DM; float* so = p.out + O_SCS + (size_t)j * 2 * DM;
        const f32x4 s0 = *(const f32x4*)(ss_in + c0), s1 = *(const f32x4*)(ss_in + DM + c0);
        const f32x4 w0 = *(const f32x4*)(p.conv_sc_w + c0), w1 = *(const f32x4*)(p.conv_sc_w + DM + c0), w2 = *(const f32x4*)(p.conv_sc_w + 2 * DM + c0);
        float y[4]; f32x4 vn; float ss = 0.f;
#pragma unroll
        for (int k = 0; k < 4; ++k) { const float v = cv[k] * hv[k]; vn[k] = v; y[k] = bv[k] * (w0[k] * s0[k] + w1[k] * s1[k] + w2[k] * v) * silu_f(z[k]); ss += y[k] * y[k]; }
        *(f32x4*)(so + c0) = s1; *(f32x4*)(so + DM + c0) = vn;
        const float tot = block_sum(ss, red); const float rs = __builtin_amdgcn_rsqf(tot * (1.0f / 2048.f) + EPS);
        u32x2 pk; pk.x = cvt_pk_bf16(y[0] * rs, y[1] * rs); pk.y = cvt_pk_bf16(y[2] * rs, y[3] * rs);
        *(u32x2*)(ymix + (size_t)R * KO + 2048 + c0) = pk;
    }
    __syncthreads();
}

__device__ void sc_item(const Params& p, int item) {
    const int tid = threadIdx.x, lane = tid & 63, w = tid >> 6;
    const bf16_t* proj = (const bf16_t*)(p.ws + WS_PROJ);
    bf16_t* ymix = (bf16_t*)(p.ws + WS_YMIX);
    float* ssq2 = (float*)(p.ws + WS_SSQ2);
    const int t0 = item * 64; const int b = t0 >> 11, tpos = t0 & 2047;
    const int pr0 = t0 + NMETA * (b + 1);
    const int c0 = w * 256 + lane * 4;
    const f32x4 w0 = *(const f32x4*)(p.conv_sc_w + c0), w1 = *(const f32x4*)(p.conv_sc_w + DM + c0), w2 = *(const f32x4*)(p.conv_sc_w + 2 * DM + c0);
    f32x4 vm2, vm1;
    {
        const int g2 = pr0 - 2, g1 = pr0 - 1;
        const u32x2 c2 = *(const u32x2*)(proj + (size_t)g2 * NP + CCS + c0), h2 = *(const u32x2*)(proj + (size_t)g2 * NP + CHS + c0);
        const u32x2 c1 = *(const u32x2*)(proj + (size_t)g1 * NP + CCS + c0), h1 = *(const u32x2*)(proj + (size_t)g1 * NP + CHS + c0);
        vm2 = (f32x4){bf_lo(c2.x) * bf_lo(h2.x), bf_hi(c2.x) * bf_hi(h2.x), bf_lo(c2.y) * bf_lo(h2.y), bf_hi(c2.y) * bf_hi(h2.y)};
        vm1 = (f32x4){bf_lo(c1.x) * bf_lo(h1.x), bf_hi(c1.x) * bf_hi(h1.x), bf_lo(c1.y) * bf_lo(h1.y), bf_hi(c1.y) * bf_hi(h1.y)};
    }
    for (int i0 = 0; i0 < 64; i0 += 4) {
        u32x2 zz[4], bb[4], cc[4], hh[4];
#pragma unroll
        for (int u = 0; u < 4; ++u) { const bf16_t* pr = proj + (size_t)(pr0 + i0 + u) * NP + c0;
            zz[u] = *(const u32x2*)(pr + CZS); bb[u] = *(const u32x2*)(pr + CBS); cc[u] = *(const u32x2*)(pr + CCS); hh[u] = *(const u32x2*)(pr + CHS); }
#pragma unroll
        for (int u = 0; u < 4; ++u) { const int t = t0 + i0 + u;
            const f32x4 v = (f32x4){bf_lo(cc[u].x) * bf_lo(hh[u].x), bf_hi(cc[u].x) * bf_hi(hh[u].x), bf_lo(cc[u].y) * bf_lo(hh[u].y), bf_hi(cc[u].y) * bf_hi(hh[u].y)};
            const f32x4 z = (f32x4){bf_lo(zz[u].x), bf_hi(zz[u].x), bf_lo(zz[u].y), bf_hi(zz[u].y)};
            const f32x4 bv = (f32x4){bf_lo(bb[u].x), bf_hi(bb[u].x), bf_lo(bb[u].y), bf_hi(bb[u].y)};
            const f32x4 cv = w0 * vm2 + w1 * vm1 + w2 * v;
            f32x4 y; float ss = 0.f;
#pragma unroll
            for (int k = 0; k < 4; ++k) { y[k] = bv[k] * cv[k] * silu_f(z[k]); ss += y[k] * y[k]; }
            ss = wave_sum(ss);
            if (lane == 0) atomicAdd(ssq2 + t, ss);
            u32x2 pk; pk.x = cvt_pk_bf16(y[0], y[1]); pk.y = cvt_pk_bf16(y[2], y[3]);
            *(u32x2*)(ymix + (size_t)t * KO + 2048 + c0) = pk;
            if ((t & 2047) == 2047) { float* so = p.out + O_SCP + (size_t)b * 2 * DM; *(f32x4*)(so + c0) = vm1; *(f32x4*)(so + DM + c0) = v; }
            vm2 = vm1; vm1 = v; }
    }
    if (tpos == 2048 - 64) {
        float* co = p.out + O_CSP + (size_t)b * 3 * DXBC;
        for (int i = tid; i < 3 * DXBC; i += 512) { const int rr = i / DXBC, col = i - rr * DXBC; co[i] = bf1(proj[(size_t)(b * BROWS + NMETA + 2045 + rr) * NP + CX + col]); }
    }
}

__device__ void sample_outproj(const Params& p, LAS unsigned char* lds) {
    const int tid = threadIdx.x, lane = tid & 63, w = tid >> 6;
    const bf16_t* ymix = (const bf16_t*)(p.ws + WS_YMIX); const bf16_t* WoutT = (const bf16_t*)(p.ws + WS_WOUT);
    float* part = (float*)(p.ws + WS_SSQ4);
    const int strip = blockIdx.x >> 1, rhalf = blockIdx.x & 1; const int n0 = strip * 16;
    const int rg = w & 3, kh = w >> 2;
    const int fr = lane & 15, fq = lane >> 4;
    const bf16_t* ap = ymix + (size_t)(YROW_S0 + rhalf * 64 + rg * 16 + fr) * KO + kh * 2048 + fq * 8;
    const bf16_t* bp = WoutT + (size_t)(n0 + fr) * KO + kh * 2048 + fq * 8;
    f32x4 acc = (f32x4){0.f, 0.f, 0.f, 0.f};
    for (int ks = 0; ks < 64; ks += 8) {
        bf16x8 a[8], b[8];
#pragma unroll
        for (int u = 0; u < 8; ++u) { a[u] = *(const bf16x8*)(ap + (ks + u) * 32); b[u] = *(const bf16x8*)(bp + (ks + u) * 32); }
#pragma unroll
        for (int u = 0; u < 8; ++u) acc = __builtin_amdgcn_mfma_f32_16x16x32_bf16(a[u], b[u], acc, 0, 0, 0);
    }
    LAS f32x4* ex = (LAS f32x4*)lds;
    if (kh == 1) ex[rg * 64 + lane] = acc;
    __syncthreads();
    if (kh == 0) {
        acc += ex[rg * 64 + lane];
#pragma unroll
        for (int i = 0; i < 4; ++i) { const int srow = rhalf * 64 + rg * 16 + fq * 4 + i; const size_t o = (size_t)srow * DM + n0 + fr;
            const float v = acc[i] + p.x_sample[o]; p.out[O_YS + o] = v;
            float q = v * v;
#pragma unroll
            for (int s = 8; s >= 1; s >>= 1) q += __shfl_xor(q, s);
            if (fr == 0) part[srow * 128 + strip] = q; }
    }
    __syncthreads();
}

__device__ void p4_final(const Params& p) {
    const int tid = threadIdx.x, lane = tid & 63, wid = tid >> 6;
    const float* s3 = (const float*)(p.ws + WS_SSQ3); const float* s4 = (const float*)(p.ws + WS_SSQ4);
    const int gw = blockIdx.x * 8 + wid, nw = gridDim.x * 8;
    for (int r = gw; r < 8192 + 128; r += nw) {
        float ss; float* o;
        if (r < 8192) { ss = lane < 32 ? s3[(size_t)r * 32 + lane] : 0.f; o = p.out + O_YP + (size_t)r * DM; }
        else { const int sr = r - 8192; ss = s4[sr * 128 + lane] + s4[sr * 128 + 64 + lane]; o = p.out + O_YS + (size_t)sr * DM; }
        ss = wave_sum(ss);
        const float rs = __builtin_amdgcn_rsqf(ss * (1.0f / 2048.f) + EPS);
#pragma unroll
        for (int i = 0; i < 8; ++i) { const f32x4 v = *(const f32x4*)(o + i * 256 + lane * 4); const f32x4 wv = *(const f32x4*)(p.final_norm_w + i * 256 + lane * 4);
            *(f32x4*)(o + i * 256 + lane * 4) = v * rs * wv; }
    }
}

__global__ void __launch_bounds__(512, 2) hymba_fwd(Params p) {
    extern __shared__ __attribute__((aligned(16))) unsigned char lds_raw[];
    LAS unsigned char* lds = (LAS unsigned char*)lds_raw;
    cg::grid_group grid = cg::this_grid();
    const int lo = p.ph_lo, hi = p.ph_hi;
#ifdef ONLY
#define IN(k) ((k) == ONLY && lo <= (k) && (k) < hi)
#else
#define IN(k) (lo <= (k) && (k) < hi)
#endif
#define SEAM(k) do { if (IN(k) && IN((k) + 1)) grid.sync(); } while (0)
    if (IN(0)) p0_prep(p, lds);
    SEAM(0);
    if (IN(1)) {
        pg8::Gemm g{(const bf16_t*)(p.ws + WS_HN), (const bf16_t*)(p.ws + WS_WIN), MP, NP, DM};
        pg8::StaticOrder S; S.init(MP, NP, (int)gridDim.x, (int)blockIdx.x);
        pg8::EpiProj E{(bf16_t*)(p.ws + WS_PROJ), NP};
        pg8::gemm_phase<pg8::EpiProj>(lds, g, S, E);
    }
    SEAM(1);
    if (IN(2)) {
        {   const int it = blockIdx.x;
#if !defined(SUB) || SUB == 0
            if (it < 128) ssd_item(p, lds, it);
#endif
#if !defined(SUB) || SUB == 1
            if (it >= 128) decode_item(p, lds, it - 128);
#endif
#if !defined(SUB) || SUB == 2
            if (it >= 128) sc_item(p, it - 128);
#endif
        }
    }
    SEAM(2);
    if (IN(3)) {
        if (blockIdx.x < 256) sample_outproj(p, lds);
        pg8::Gemm g{(const bf16_t*)(p.ws + WS_YMIX), (const bf16_t*)(p.ws + WS_WOUT), 8192, DM, KO};
        pg8::StaticOrder S; S.init(8192, DM, (int)gridDim.x, (int)blockIdx.x);
        LAS float* tab = (LAS float*)(lds + pg8::STAGE_BYTES);
        { pg8::Unit u0; S.next(0, u0);
          if (threadIdx.x < 256) { const int r = u0.pm * 256 + threadIdx.x; const float s1 = ((const float*)(p.ws + WS_SSQ1))[r], s2 = ((const float*)(p.ws + WS_SSQ2))[r];
              const float q1 = s1 * (1.0f / 2048.f) + EPS, q2 = s2 * (1.0f / 2048.f) + EPS;
              tab[threadIdx.x] = __builtin_sqrtf(q2 / q1); tab[256 + threadIdx.x] = __builtin_amdgcn_rsqf(q2); }
          __syncthreads(); }
        pg8::EpiOut E{p.out + O_YP, p.x_prompt, tab, (float*)(p.ws + WS_SSQ3)};
        pg8::gemm_phase<pg8::EpiOut>(lds, g, S, E);
    }
    SEAM(3);
    if (IN(4)) p4_final(p);
#undef IN
#undef SEAM
}

extern "C" void kernel_launch(void* const* d_in, const int* in_sizes, int n_in, void* d_out, int out_size, void* d_ws, size_t ws_size, hipStream_t stream) {
    static int grid = 0;
    if (grid == 0) {
        int dev = 0, cus = 0, per_cu = 0;
        hipGetDevice(&dev); hipDeviceGetAttribute(&cus, hipDeviceAttributeMultiprocessorCount, dev);
        hipFuncSetAttribute((const void*)hymba_fwd, hipFuncAttributeMaxDynamicSharedMemorySize, LDS_BYTES);
        hipOccupancyMaxActiveBlocksPerMultiprocessor(&per_cu, (const void*)hymba_fwd, 512, LDS_BYTES);
        if (per_cu < 1) per_cu = 1;
        grid = cus * 1;
        if (grid > 256) grid = 256;
        if (ws_size < WS_END) { fprintf(stderr, "workspace too small: %zu < %zu\n", ws_size, (size_t)WS_END); }
    }
    Params p{};
    p.x_prompt = (const float*)d_in[0]; p.x_sample = (const float*)d_in[1]; p.state_ssm = (const float*)d_in[2]; p.state_ssd_conv = (const float*)d_in[3];
    p.state_short_conv = (const float*)d_in[4]; p.meta = (const float*)d_in[5]; p.norm_w = (const float*)d_in[6]; p.w_in = (const float*)d_in[7];
    p.conv_ssd_w = (const float*)d_in[8]; p.conv_ssd_b = (const float*)d_in[9]; p.dt_bias = (const float*)d_in[10]; p.a_log = (const float*)d_in[11];
    p.d_skip = (const float*)d_in[12]; p.ssd_norm_w = (const float*)d_in[13]; p.conv_sc_w = (const float*)d_in[14]; p.sc_norm_w = (const float*)d_in[15];
    p.w_out = (const float*)d_in[16]; p.final_norm_w = (const float*)d_in[17];
    p.out = (float*)d_out; p.ws = (unsigned char*)d_ws;
#if N_LAUNCH == 1
    p.ph_lo = 0; p.ph_hi = 5;
    void* args[] = {&p};
    hipError_t e = hipLaunchCooperativeKernel((const void*)hymba_fwd, dim3(grid), dim3(512), args, LDS_BYTES, stream);
    if (e != hipSuccess) fprintf(stderr, "cooperative launch failed: %s (grid %d)\n", hipGetErrorString(e), grid);
#else
    for (int ph = 0; ph < 5; ++ph) {
        p.ph_lo = ph; p.ph_hi = ph + 1;
        hipLaunchKernelGGL(hymba_fwd, dim3(grid), dim3(512), LDS_BYTES, stream, p);
    }
#endif
}
```

```cpp
#include <hip/hip_runtime.h>
#include <hip/hip_cooperative_groups.h>
#include <cstdio>
namespace cg = cooperative_groups;

#define LAS __attribute__((address_space(3)))
typedef unsigned short bf16_t;
typedef short bf16x8 __attribute__((ext_vector_type(8)));
typedef float f32x4 __attribute__((ext_vector_type(4)));
typedef float f32x16 __attribute__((ext_vector_type(16)));
typedef unsigned u32x4 __attribute__((ext_vector_type(4)));
typedef unsigned u32x2 __attribute__((ext_vector_type(2)));

#ifndef N_LAUNCH
#define N_LAUNCH 1
#endif
#define REP0 1
#define REP1 1
#define REP3 1
#define SCHED {0,5,0},{5,6,0}

constexpr int DM = 2048;
constexpr int SEQ = 2048, NB = 4, NS = 128, NMETA = 16;
constexpr int NPROJ = 13344;
constexpr int NP = 13568;
constexpr int MP = 8448;
constexpr int BROWS = 2064;
constexpr int ROW_S0 = 8256;
constexpr int ROW_END = 8384;
constexpr int YROW_S0 = 8192;
constexpr int DXBC = 3072;
constexpr int CZ = 0, CX = 2048, CBm = 4096, CCm = 4608, CZS = 5120, CBS = 7168, CCS = 9216, CHS = 11264, CDT = 13312;
constexpr int KO = 4096;
constexpr float EPS = 1e-5f;

constexpr size_t O_YP = 0;
constexpr size_t O_YS = O_YP + (size_t)NB * SEQ * DM;
constexpr size_t O_SSMP = O_YS + (size_t)NS * DM;
constexpr size_t O_CSP = O_SSMP + (size_t)NB * 32 * 64 * 128;
constexpr size_t O_SCP = O_CSP + (size_t)NB * 3 * DXBC;
constexpr size_t O_SSMS = O_SCP + (size_t)NB * 2 * DM;
constexpr size_t O_CSS = O_SSMS + (size_t)NS * 32 * 64 * 128;
constexpr size_t O_SCS = O_CSS + (size_t)NS * 3 * DXBC;

constexpr size_t WS_WIN = 0;
constexpr size_t WS_WOUT = WS_WIN + (size_t)NP * DM * 2;
constexpr size_t WS_HN = WS_WOUT + (size_t)DM * KO * 2;
constexpr size_t WS_PROJ = WS_HN + (size_t)MP * DM * 2;
constexpr size_t WS_YMIX = WS_PROJ + (size_t)MP * NP * 2;
constexpr size_t WS_SSQ1 = WS_YMIX + (size_t)MP * KO * 2;
constexpr size_t WS_SSQ2 = WS_SSQ1 + (size_t)MP * 4;
constexpr size_t WS_SSQ3 = WS_SSQ2 + (size_t)MP * 4;
constexpr size_t WS_SSQ4 = WS_SSQ3 + (size_t)8192 * 32 * 4;
constexpr size_t WS_XC = WS_SSQ4 + (size_t)128 * 128 * 4;
constexpr size_t WS_DTV = WS_XC + (size_t)MP * DXBC * 2;
constexpr size_t WS_END = WS_DTV + (size_t)MP * 32 * 4;

constexpr int LDS_BYTES = 147456;

struct Params {
    const float* x_prompt; const float* x_sample; const float* state_ssm; const float* state_ssd_conv; const float* state_short_conv;
    const float* meta; const float* norm_w; const float* w_in; const float* conv_ssd_w; const float* conv_ssd_b; const float* dt_bias;
    const float* a_log; const float* d_skip; const float* ssd_norm_w; const float* conv_sc_w; const float* sc_norm_w; const float* w_out;
    const float* final_norm_w;
    float* out; unsigned char* ws;
    int ph_lo, ph_hi, flags, pad;
};

__device__ __forceinline__ unsigned cvt_pk_bf16(float lo, float hi) { unsigned r; asm("v_cvt_pk_bf16_f32 %0, %1, %2" : "=v"(r) : "v"(lo), "v"(hi)); return r; }
__device__ __forceinline__ float bf_lo(unsigned u) { return __uint_as_float(u << 16); }
__device__ __forceinline__ float bf_hi(unsigned u) { return __uint_as_float(u & 0xffff0000u); }
__device__ __forceinline__ float bf1(bf16_t u) { return __uint_as_float(((unsigned)u) << 16); }
__device__ __forceinline__ float silu_f(float x) { return x * __builtin_amdgcn_rcpf(1.0f + __expf(-x)); }
__device__ __forceinline__ float softplus_f(float x) { return x > 20.f ? x : log1pf(__expf(x)); }
__device__ __forceinline__ float wave_sum(float v) {
#pragma unroll
    for (int o = 32; o >= 1; o >>= 1) v += __shfl_xor(v, o);
    return v;
}
__device__ __forceinline__ void unpack8(const u32x4 u, float (&f)[8]) {
    f[0] = bf_lo(u.x); f[1] = bf_hi(u.x); f[2] = bf_lo(u.y); f[3] = bf_hi(u.y); f[4] = bf_lo(u.z); f[5] = bf_hi(u.z); f[6] = bf_lo(u.w); f[7] = bf_hi(u.w);
}

namespace pg8 {
constexpr int BM = 256, BK = 64, HALF = 128, HTB = HALF * BK * 2, STAGE_BYTES = 8 * HTB, NXCD = 8, WGM = 8;
__device__ __forceinline__ int lds_byte(int r, int c) { const int st = (r >> 4) * 2 + (c >> 5), rr = r & 15, cc = c & 31, ob = rr * 64 + cc * 2; return st * 1024 + (ob ^ (((ob >> 9) & 1) << 5)); }
__device__ __forceinline__ void stage_rc(int b, int& R, int& C) { const int st = b / 1024, sb = b % 1024, swz = sb ^ (((sb >> 9) & 1) << 5); R = (st >> 1) * 16 + swz / 64; C = (st & 1) * 32 + (swz % 64) / 2; }
__device__ __forceinline__ int perm32(int rho) { const int n = rho >> 4, i = rho & 15; return 8 * (i >> 2) + 4 * n + (i & 3); }
struct Unit { int pm, pn; };
struct Gemm { const bf16_t* A; const bf16_t* Bt; int M, N, K; };
struct StaticOrder {
    int nM, nN, nwg, G, c;
    __device__ void init(int M, int N, int G_, int c_) { nM = M / BM; nN = N / BM; nwg = nM * nN; G = G_; c = c_; }
    __device__ bool next(int i, Unit& u) const {
        const long L = (long)i * G + c; if (L >= nwg) return false;
        int wgid = (int)L; { const int q = nwg / NXCD, r = nwg % NXCD, xcd = wgid % NXCD, off = wgid / NXCD; wgid = (xcd < r ? xcd * (q + 1) : r * (q + 1) + (xcd - r) * q) + off; }
        const int nig = WGM * nN, gid = wgid / nig, fm = gid * WGM, gsz = (nM - fm) < WGM ? (nM - fm) : WGM;
        u.pm = fm + ((wgid % nig) % gsz); u.pn = (wgid % nig) / gsz; return true;
    }
};

struct EpiProj {
    static constexpr bool PERM = true, MID = false;
    bf16_t* O; int ldc;
    __device__ __forceinline__ void mid(f32x4 (&acc)[2][2][4][2], const Unit& u, int wr, int wc, int fr, int fq) const {}
    __device__ __forceinline__ void operator()(const f32x4 (&acc)[2][2][4][2], const Unit& u, int wr, int wc, int fr, int fq) const {
        const int row0 = u.pm * BM + wr * 64 + fr; const int col0 = u.pn * BM + wc * 32 + 8 * fq;
#pragma unroll
        for (int ai = 0; ai < 2; ++ai)
#pragma unroll
            for (int m = 0; m < 4; ++m) { bf16_t* rowp = O + (size_t)(row0 + ai * HALF + m * 16) * ldc + col0;
#pragma unroll
                for (int bj = 0; bj < 2; ++bj) { const f32x4 v0 = acc[ai][bj][m][0], v1 = acc[ai][bj][m][1];
                    u32x4 w; w.x = cvt_pk_bf16(v0[0], v0[1]); w.y = cvt_pk_bf16(v0[2], v0[3]); w.z = cvt_pk_bf16(v1[0], v1[1]); w.w = cvt_pk_bf16(v1[2], v1[3]);
                    *(u32x4*)(rowp + bj * HALF) = w; } }
    }
};
struct EpiOut {
    static constexpr bool PERM = false, MID = true;
    float* C; const float* resid; LAS const float* tab; float* part;
    __device__ __forceinline__ void mid(f32x4 (&acc)[2][2][4][2], const Unit& u, int wr, int wc, int fr, int fq) const {
#pragma unroll
        for (int ai = 0; ai < 2; ++ai)
#pragma unroll
            for (int m = 0; m < 4; ++m) { const float f = tab[wr * 64 + fr + ai * HALF + m * 16];
#pragma unroll
                for (int bj = 0; bj < 2; ++bj)
#pragma unroll
                    for (int n = 0; n < 2; ++n) acc[ai][bj][m][n] *= f;
                asm volatile("" ::: "memory"); }
    }
    __device__ __forceinline__ void operator()(const f32x4 (&acc)[2][2][4][2], const Unit& u, int wr, int wc, int fr, int fq) const {
        const int row0 = u.pm * BM + wr * 64 + fr, col0 = u.pn * BM + wc * 32 + 4 * fq;
#pragma unroll
        for (int ai = 0; ai < 2; ++ai)
#pragma unroll
            for (int m = 0; m < 4; ++m) { const int r = row0 + ai * HALF + m * 16;
                const float rs = tab[256 + wr * 64 + fr + ai * HALF + m * 16];
                const size_t off = (size_t)r * DM + col0; float ss = 0.f;
#pragma unroll
                for (int bj = 0; bj < 2; ++bj)
#pragma unroll
                    for (int n = 0; n < 2; ++n) { const f32x4 x = *(const f32x4*)(resid + off + bj * HALF + n * 16); const f32x4 v = acc[ai][bj][m][n] * rs + x;
                        *(f32x4*)(C + off + bj * HALF + n * 16) = v; ss += (v[0] * v[0] + v[1] * v[1]) + (v[2] * v[2] + v[3] * v[3]); }
                ss += __shfl_xor(ss, 16); ss += __shfl_xor(ss, 32);
                if (fq == 0) part[(size_t)r * 32 + u.pn * 4 + wc] = ss;
                asm volatile("" ::: "memory"); }
    }
};

template <class Epi>
__device__ __forceinline__ void gemm_phase(LAS unsigned char* lds, const Gemm g, const StaticOrder& S, const Epi& E) {
    const int tid = threadIdx.x, wid = __builtin_amdgcn_readfirstlane(tid >> 6), lane = tid & 63, wr = wid >> 2, wc = wid & 3, fr = lane & 15, fq = lane >> 4;
    const int K = g.K, nt = K / BK;
    unsigned voffA[2], voffB[2];
#pragma unroll
    for (int i = 0; i < 2; ++i) { int R, C; stage_rc(tid * 16 + i * 8192, R, C); const int Rb = Epi::PERM ? ((R & ~31) + perm32(R & 31)) : R;
        voffA[i] = (unsigned)(R * K + C) * 2u; voffB[i] = (unsigned)(Rb * K + C) * 2u; }
    const size_t kstep = (size_t)(BK * 2);
    const size_t hstep = (size_t)HALF * K * 2;
    const size_t tstep = 2 * hstep;
    const unsigned ldsw = (unsigned)wid * 1024u;
    const int aoff = lds_byte(wr * 64 + fr, fq * 8), boff = lds_byte(wc * 32 + fr, fq * 8);
#define PG8_SA(b, h) (((b) * 2 + (h)) * HTB)
#define PG8_SB(b, h) ((4 + (b) * 2 + (h)) * HTB)
#define PG8_STAGE(bufoff, gbase, voff) do { _Pragma("unroll") for (int _i = 0; _i < 2; ++_i) \
        __builtin_amdgcn_global_load_lds((const unsigned*)((const char*)(gbase) + (voff)[_i]), (LAS unsigned*)(lds + (bufoff) + ldsw + _i * 8192), 16, 0, 0); } while (0)
#define PG8_LDA(dst, b, h) do { _Pragma("unroll") for (int m = 0; m < 4; ++m) _Pragma("unroll") for (int k = 0; k < 2; ++k) dst[m][k] = *(const LAS bf16x8*)(lds + PG8_SA(b, h) + aoff + m * 2048 + k * 1024); } while (0)
#define PG8_LDB(dst, b, h) do { _Pragma("unroll") for (int n = 0; n < 2; ++n) _Pragma("unroll") for (int k = 0; k < 2; ++k) dst[n][k] = *(const LAS bf16x8*)(lds + PG8_SB(b, h) + boff + n * 2048 + k * 1024); } while (0)
#define PG8_MMA(ai, bj, At, Bt) do { __builtin_amdgcn_s_setprio(1); _Pragma("unroll") for (int m = 0; m < 4; ++m) _Pragma("unroll") for (int n = 0; n < 2; ++n) _Pragma("unroll") for (int k = 0; k < 2; ++k) \
        acc[ai][bj][m][n] = __builtin_amdgcn_mfma_f32_16x16x32_bf16(Bt[n][k], At[m][k], acc[ai][bj][m][n], 0, 0, 0); __builtin_amdgcn_s_setprio(0); } while (0)
#define PG8_WAIT_V(n) asm volatile("s_waitcnt vmcnt(" #n ")" ::: "memory")
#define PG8_WAIT_L(n) asm volatile("s_waitcnt lgkmcnt(" #n ")" ::: "memory")
#define PG8_BAR __builtin_amdgcn_s_barrier()
#define PG8_SCHED __builtin_amdgcn_sched_barrier(0)
    Unit cur, nxt; int ui = 0;
    if (!S.next(0, cur)) return;
    f32x4 acc[2][2][4][2];
#pragma unroll
    for (int a = 0; a < 2; ++a)
#pragma unroll
        for (int b = 0; b < 2; ++b)
#pragma unroll
            for (int m = 0; m < 4; ++m)
#pragma unroll
                for (int n = 0; n < 2; ++n) acc[a][b][m][n] = (f32x4){0.f, 0.f, 0.f, 0.f};
    bf16x8 At[4][2], B0[2][2], B1[2][2];
    const char* cA = (const char*)g.A + (size_t)cur.pm * tstep; const char* cB = (const char*)g.Bt + (size_t)cur.pn * tstep;
    PG8_STAGE(PG8_SB(0, 0), cB, voffB); PG8_STAGE(PG8_SA(0, 0), cA, voffA); PG8_STAGE(PG8_SB(0, 1), cB + hstep, voffB); PG8_STAGE(PG8_SA(0, 1), cA + hstep, voffA);
    if (wr == 1) PG8_BAR;
    PG8_WAIT_V(4); PG8_BAR;
    PG8_STAGE(PG8_SB(1, 0), cB + kstep, voffB); PG8_STAGE(PG8_SA(1, 0), cA + kstep, voffA); PG8_STAGE(PG8_SB(1, 1), cB + hstep + kstep, voffB);
    PG8_WAIT_V(6); PG8_BAR;
    for (;;) {
        const bool has_next = S.next(ui + 1, nxt);
        const char* nA = has_next ? (const char*)g.A + (size_t)nxt.pm * tstep : cA; const char* nB = has_next ? (const char*)g.Bt + (size_t)nxt.pn * tstep : cB;
        for (int t = 0; t < nt; t += 2) {
            const bool last = (t == nt - 2);
            const char* a1 = cA + (size_t)(t + 1) * kstep;
            const char* a2 = last ? nA : cA + (size_t)(t + 2) * kstep; const char* b2 = last ? nB : cB + (size_t)(t + 2) * kstep;
            const char* a3 = a2 + kstep; const char* b3 = b2 + kstep;
            if constexpr (Epi::MID) { if (t == (nt >> 1)) E.mid(acc, cur, wr, wc, fr, fq); }
            PG8_LDB(B0, 0, 0); PG8_SCHED; PG8_LDA(At, 0, 0); PG8_STAGE(PG8_SA(1, 1), a1 + hstep, voffA);
            PG8_WAIT_L(8); PG8_BAR; PG8_WAIT_L(0); PG8_MMA(0, 0, At, B0); PG8_BAR; PG8_SCHED;
            PG8_LDB(B1, 0, 1); PG8_STAGE(PG8_SB(0, 0), b2, voffB);
            PG8_BAR; PG8_WAIT_L(0); PG8_MMA(0, 1, At, B1); PG8_BAR;
            PG8_LDA(At, 0, 1); PG8_STAGE(PG8_SA(0, 0), a2, voffA);
            PG8_BAR; PG8_WAIT_L(0); PG8_MMA(1, 0, At, B0); PG8_BAR; PG8_SCHED;
            PG8_STAGE(PG8_SB(0, 1), b2 + hstep, voffB);
            PG8_WAIT_V(6); PG8_BAR; PG8_MMA(1, 1, At, B1); PG8_BAR;
            PG8_LDB(B0, 1, 0); PG8_SCHED; PG8_LDA(At, 1, 0); PG8_STAGE(PG8_SA(0, 1), a2 + hstep, voffA);
            PG8_WAIT_L(8); PG8_BAR; PG8_WAIT_L(0); PG8_MMA(0, 0, At, B0); PG8_BAR; PG8_SCHED;
            PG8_LDB(B1, 1, 1); PG8_STAGE(PG8_SB(1, 0), b3, voffB);
            PG8_BAR; PG8_WAIT_L(0); PG8_MMA(0, 1, At, B1); PG8_BAR;
            PG8_LDA(At, 1, 1); PG8_STAGE(PG8_SA(1, 0), a3, voffA);
            PG8_BAR; PG8_WAIT_L(0); PG8_MMA(1, 0, At, B0); PG8_BAR; PG8_SCHED;
            PG8_STAGE(PG8_SB(1, 1), b3 + hstep, voffB);
            PG8_WAIT_V(6); PG8_BAR; PG8_MMA(1, 1, At, B1); PG8_BAR;
        }
        E(acc, cur, wr, wc, fr, fq);
        if (!has_next) break;
#pragma unroll
        for (int a = 0; a < 2; ++a)
#pragma unroll
            for (int b = 0; b < 2; ++b)
#pragma unroll
                for (int m = 0; m < 4; ++m)
#pragma unroll
                    for (int n = 0; n < 2; ++n) acc[a][b][m][n] = (f32x4){0.f, 0.f, 0.f, 0.f};
        cur = nxt; cA = nA; cB = nB; ++ui;
    }
    PG8_WAIT_V(0);
    if (wr == 0) PG8_BAR;
    PG8_BAR;
#undef PG8_SA
#undef PG8_SB
#undef PG8_STAGE
#undef PG8_LDA
#undef PG8_LDB
#undef PG8_MMA
#undef PG8_WAIT_V
#undef PG8_WAIT_L
#undef PG8_BAR
#undef PG8_SCHED
}
}

__device__ __forceinline__ void tr_tile(LAS unsigned char* lds, const float* __restrict__ src, int spitch, int scol0, int nvalid, int k0,
                                        bf16_t* __restrict__ dst, int dpitch, int n0, const float* __restrict__ sc0, const float* __restrict__ sc1) {
    const int tid = threadIdx.x;
    LAS unsigned* T = (LAS unsigned*)lds;
    const int nq = tid & 15, kp = tid >> 4;
#pragma unroll
    for (int pass = 0; pass < 2; ++pass) {
        const int kk = pass * 64 + kp * 2;
        const int kg = k0 + kk;
        f32x4 r0 = (f32x4){0.f, 0.f, 0.f, 0.f}, r1 = r0;
        if (nq * 4 < nvalid) {
            r0 = *(const f32x4*)(src + (size_t)kg * spitch + scol0 + nq * 4);
            r1 = *(const f32x4*)(src + (size_t)(kg + 1) * spitch + scol0 + nq * 4);
        }
        float s0 = 1.f, s1 = 1.f;
        if (sc0) { s0 = (kg < 2048) ? sc0[kg] : sc1[kg - 2048]; s1 = (kg + 1 < 2048) ? sc0[kg + 1] : sc1[kg + 1 - 2048]; }
#pragma unroll
        for (int j = 0; j < 4; ++j) T[(nq * 4 + j) * 68 + (kk >> 1)] = cvt_pk_bf16(r0[j] * s0, r1[j] * s1);
    }
    __syncthreads();
#pragma unroll
    for (int i = 0; i < 2; ++i) {
        const int ch = tid + i * 512; const int n = ch >> 4, c16 = ch & 15;
        const u32x4 v = *(const LAS u32x4*)(T + n * 68 + c16 * 4);
        *(u32x4*)(dst + (size_t)(n0 + n) * dpitch + k0 + c16 * 8) = v;
    }
    __syncthreads();
}

__device__ void p0_prep(const Params& p, LAS unsigned char* lds) {
    const int tid = threadIdx.x, lane = tid & 63, wid = tid >> 6;
    bf16_t* WinT = (bf16_t*)(p.ws + WS_WIN); bf16_t* WoutT = (bf16_t*)(p.ws + WS_WOUT); bf16_t* hn = (bf16_t*)(p.ws + WS_HN);
    { float* s1 = (float*)(p.ws + WS_SSQ1); for (int i = blockIdx.x * 512 + tid; i < 2 * MP; i += gridDim.x * 512) s1[i] = 0.f; }
    constexpr int T_IN = 212 * 16, T_OUT = 32 * 32;
    for (int t = blockIdx.x; t < T_IN + T_OUT; t += gridDim.x) {
        if (t < T_IN) {
            const int nt_ = t >> 4, kt = t & 15; const int n0 = nt_ * 64;
            int scol, nvalid;
            if (n0 < 5120) { scol = n0; nvalid = 64; }
            else if (n0 < 13312) { scol = n0 + 32; nvalid = 64; }
            else if (n0 == 13312) { scol = 5120; nvalid = 32; }
            else { scol = 0; nvalid = 0; }
            tr_tile(lds, p.w_in, NPROJ, scol, nvalid, kt * 128, WinT, DM, n0, nullptr, nullptr);
        } else {
            const int tt = t - T_IN; const int nt_ = tt >> 5, kt = tt & 31;
            tr_tile(lds, p.w_out, DM, nt_ * 64, 64, kt * 128, WoutT, KO, nt_ * 64, p.ssd_norm_w, p.sc_norm_w);
        }
    }
    const int gw = blockIdx.x * 8 + wid, nw = gridDim.x * 8;
    for (int r = gw; r < MP; r += nw) {
        bf16_t* o = hn + (size_t)r * DM;
        if (r >= ROW_END) {
#pragma unroll
            for (int i = 0; i < 8; ++i) *(u32x2*)(o + i * 256 + lane * 4) = (u32x2){0u, 0u};
            continue;
        }
        const float* src;
        if (r < ROW_S0) { const int bb = r / BROWS, q = r - bb * BROWS; src = q < NMETA ? p.meta + (size_t)q * DM : p.x_prompt + ((size_t)bb * SEQ + (q - NMETA)) * DM; }
        else src = p.x_sample + (size_t)(r - ROW_S0) * DM;
        f32x4 v[8]; float ss = 0.f;
#pragma unroll
        for (int i = 0; i < 8; ++i) { v[i] = *(const f32x4*)(src + i * 256 + lane * 4); ss += (v[i][0] * v[i][0] + v[i][1] * v[i][1]) + (v[i][2] * v[i][2] + v[i][3] * v[i][3]); }
        ss = wave_sum(ss);
        const float rs = __builtin_amdgcn_rsqf(ss * (1.0f / 2048.f) + EPS);
#pragma unroll
        for (int i = 0; i < 8; ++i) { const f32x4 w = *(const f32x4*)(p.norm_w + i * 256 + lane * 4);
            u32x2 pk; pk.x = cvt_pk_bf16(v[i][0] * rs * w[0], v[i][1] * rs * w[1]); pk.y = cvt_pk_bf16(v[i][2] * rs * w[2], v[i][3] * rs * w[3]);
            *(u32x2*)(o + i * 256 + lane * 4) = pk; }
    }
}

constexpr int PIT = 272;
constexpr int L_CS = 0, L_BS = 34816, L_BT = 69632, L_XT = 104448, L_SB = 121856, L_SC = 139264;
constexpr int F_DT = 0, F_ACS = 256, F_WV = 512, F_SSL = 768, F_AEND = 1024;

__device__ __forceinline__ void scan_load(const Params& p, int rb, int lmin, int h, float& d0, float& d1) {
    const int lane = threadIdx.x & 63; const float* dtv = (const float*)(p.ws + WS_DTV);
    const int l0 = 2 * lane, g0 = max(rb + l0, 0), g1 = max(rb + l0 + 1, 0);
    d0 = dtv[g0 * 32 + h]; d1 = dtv[g1 * 32 + h];
    d0 = l0 >= lmin ? d0 : 0.f; d1 = l0 + 1 >= lmin ? d1 : 0.f;
}
__device__ __forceinline__ void scan_finish(LAS float* sm, int buf, float d0, float d1, float a_neg) {
    const int lane = threadIdx.x & 63;
    const float x0 = d0 * a_neg, x1 = d1 * a_neg;
    float s = x0 + x1;
#pragma unroll
    for (int o = 1; o < 64; o <<= 1) { const float t = __shfl_up(s, o); if (lane >= o) s += t; }
    const float c1 = s, c0 = s - x1;
    const float aend = __shfl(s, 63);
    sm[F_DT + buf * 128 + 2 * lane] = d0; sm[F_DT + buf * 128 + 2 * lane + 1] = d1;
    sm[F_ACS + buf * 128 + 2 * lane] = c0; sm[F_ACS + buf * 128 + 2 * lane + 1] = c1;
    sm[F_WV + buf * 128 + 2 * lane] = d0 * __expf(aend - c0); sm[F_WV + buf * 128 + 2 * lane + 1] = d1 * __expf(aend - c1);
    if (lane == 0) sm[F_AEND + buf] = aend;
}

template <int NR, class Store>
__device__ __forceinline__ void conv_rows(const Params& p, int rb, int lmin, int l0, int pcol, int wcol, Store&& st) {
    const bf16_t* proj = (const bf16_t*)(p.ws + WS_PROJ);
    u32x4 raw[NR + 3];
#pragma unroll
    for (int i = 0; i < NR + 3; ++i) { const int l = l0 - 3 + i; const int g = max(rb + l, 0);
        raw[i] = *(const u32x4*)(proj + (size_t)g * NP + pcol);
        if (l < lmin) raw[i] = (u32x4){0u, 0u, 0u, 0u}; }
    float w[4][8], bias[8];
#pragma unroll
    for (int k = 0; k < 4; ++k) { const f32x4 a = *(const f32x4*)(p.conv_ssd_w + k * DXBC + wcol), b = *(const f32x4*)(p.conv_ssd_w + k * DXBC + wcol + 4);
        w[k][0] = a[0]; w[k][1] = a[1]; w[k][2] = a[2]; w[k][3] = a[3]; w[k][4] = b[0]; w[k][5] = b[1]; w[k][6] = b[2]; w[k][7] = b[3]; }
    { const f32x4 a = *(const f32x4*)(p.conv_ssd_b + wcol), b = *(const f32x4*)(p.conv_ssd_b + wcol + 4);
      bias[0] = a[0]; bias[1] = a[1]; bias[2] = a[2]; bias[3] = a[3]; bias[4] = b[0]; bias[5] = b[1]; bias[6] = b[2]; bias[7] = b[3]; }
    float h0[8], h1[8], h2[8], cur[8];
    unpack8(raw[0], h0); unpack8(raw[1], h1); unpack8(raw[2], h2);
#pragma unroll
    for (int i = 0; i < NR; ++i) {
        unpack8(raw[i + 3], cur);
        float o[8];
#pragma unroll
        for (int j = 0; j < 8; ++j) { const float a = bias[j] + w[0][j] * h0[j] + w[1][j] * h1[j] + w[2][j] * h2[j] + w[3][j] * cur[j]; o[j] = silu_f(a); }
        st(i, o);
#pragma unroll
        for (int j = 0; j < 8; ++j) { h0[j] = h1[j]; h1[j] = h2[j]; h2[j] = cur[j]; }
    }
}

__device__ void conv_pre(const Params& p) {
    const bf16_t* proj = (const bf16_t*)(p.ws + WS_PROJ);
    bf16_t* xc = (bf16_t*)(p.ws + WS_XC); float* dtv = (float*)(p.ws + WS_DTV);
    const int gt = blockIdx.x * 512 + threadIdx.x, nthr = gridDim.x * 512;
    for (int T = gt; T < (ROW_S0 / 4) * 384; T += nthr) {
        const int cgp = T % 384, rg = T / 384; const int R0 = rg * 4, col = cgp * 8;
        const int lmin = (R0 % BROWS) != 0 ? -3 : 0;
        conv_rows<4>(p, R0, lmin, 0, CX + col, col, [&](int i, const float (&o)[8]) {
            u32x4 pk; pk.x = cvt_pk_bf16(o[0], o[1]); pk.y = cvt_pk_bf16(o[2], o[3]); pk.z = cvt_pk_bf16(o[4], o[5]); pk.w = cvt_pk_bf16(o[6], o[7]);
            *(u32x4*)(xc + (size_t)(R0 + i) * DXBC + col) = pk; });
    }
    for (int T = gt; T < ROW_S0 * 32; T += nthr) { const int R = T >> 5, h = T & 31; dtv[T] = softplus_f(bf1(proj[(size_t)R * NP + CDT + h]) + p.dt_bias[h]); }
}

__device__ void ssd_item(const Params& p, LAS unsigned char* lds, int item) {
    const int tid = threadIdx.x, lane = tid & 63, w = __builtin_amdgcn_readfirstlane(tid >> 6), r = lane & 31, hh = lane >> 5;
    const int pair = (item & 7) + 8 * (item >> 6), hg = (item >> 3) & 7;
    const int b = pair >> 2, g = pair & 3, h = g * 8 + hg;
    const bf16_t* proj = (const bf16_t*)(p.ws + WS_PROJ);
    const bf16_t* xc = (const bf16_t*)(p.ws + WS_XC);
    bf16_t* ymix = (bf16_t*)(p.ws + WS_YMIX);
    float* ssq1 = (float*)(p.ws + WS_SSQ1);
    LAS float* sm = (LAS float*)(lds + L_SC);
    const float a_neg = -__expf(p.a_log[h]), Dh = p.d_skip[h];
    const int l0 = (((tid >> 2) & 3) | ((tid >> 6) << 2)) * 4, n0 = ((tid & 3) | (((tid >> 4) & 3) << 2)) * 8; const int xl0 = (tid >> 3) * 2, p0 = (tid & 7) * 8;
    const int colB = 2048 + g * 128 + n0, colC = colB + 512, colX = h * 64 + p0;
    u32x4 pB[4], pC[4], pX[2];
#define SSD_PREFETCH(RB) do { \
        _Pragma("unroll") for (int i = 0; i < 4; ++i) { const size_t gg = (size_t)max((RB) + l0 + i, 0) * DXBC; pB[i] = *(const u32x4*)(xc + gg + colB); pC[i] = *(const u32x4*)(xc + gg + colC); } \
        _Pragma("unroll") for (int i = 0; i < 2; ++i) { const size_t gg = (size_t)max((RB) + xl0 + i, 0) * DXBC; pX[i] = *(const u32x4*)(xc + gg + colX); } } while (0)
    SSD_PREFETCH(b * BROWS - 112);
    for (int i = tid; i < 17408 / 4; i += 512) ((LAS unsigned*)(lds + L_SB))[i] = 0u;
    if (w == 1) { float d0, d1; scan_load(p, b * BROWS - 112, 112, h, d0, d1); scan_finish(sm, 0, d0, d1, a_neg); }
    f32x16 accS;
#pragma unroll
    for (int i = 0; i < 16; ++i) accS[i] = 0.f;
    const int lt = w < 4 ? (w >> 1) : 3 - ((w - 4) >> 1), pt = w & 1, pt2 = w >> 2, nt = w & 3;
    __syncthreads();
    for (int c = 0; c <= 16; ++c) {
        const int buf = c & 1; const int rb = b * BROWS + NMETA + (c - 1) * 128, lmin = (c == 0) ? 112 : -3; const int base = b * SEQ + (c - 1) * 128;
        {
            unsigned bt[8][2], xt[8];
#pragma unroll
            for (int i = 0; i < 4; ++i) {
                const bool valid = (l0 + i) >= lmin;
                const u32x4 vb = valid ? pB[i] : (u32x4){0u, 0u, 0u, 0u}, vc = valid ? pC[i] : (u32x4){0u, 0u, 0u, 0u};
                *(LAS u32x4*)(lds + L_BS + (l0 + i) * PIT + n0 * 2) = vb;
                *(LAS u32x4*)(lds + L_CS + (l0 + i) * PIT + n0 * 2) = vc;
                float f[8]; unpack8(vb, f);
                const float wl = sm[F_WV + buf * 128 + l0 + i];
#pragma unroll
                for (int j = 0; j < 8; ++j) { const unsigned q = cvt_pk_bf16(f[j] * wl, 0.f);
                    if (i & 1) bt[j][i >> 1] |= q << 16; else bt[j][i >> 1] = q & 0xffffu; }
            }
#pragma unroll
            for (int j = 0; j < 8; ++j) *(LAS u32x2*)(lds + L_BT + (n0 + j) * PIT + l0 * 2) = (u32x2){bt[j][0], bt[j][1]};
#pragma unroll
            for (int i = 0; i < 2; ++i) {
                const bool valid = (xl0 + i) >= lmin;
                const u32x4 vx = valid ? pX[i] : (u32x4){0u, 0u, 0u, 0u};
                const unsigned ws4[4] = {vx.x, vx.y, vx.z, vx.w};
#pragma unroll
                for (int j = 0; j < 8; ++j) { const unsigned q = (j & 1) ? (ws4[j >> 1] >> 16) : (ws4[j >> 1] & 0xffffu);
                    if (i & 1) xt[j] |= q << 16; else xt[j] = q; }
            }
#pragma unroll
            for (int j = 0; j < 8; ++j) *(LAS unsigned*)(lds + L_XT + (p0 + j) * PIT + xl0 * 2) = xt[j];
        }
        __syncthreads();
        f32x16 cb0, cb1;
#pragma unroll
        for (int i = 0; i < 16; ++i) { cb0[i] = 0.f; cb1[i] = 0.f; }
        const int st0 = 2 * (w & 1);
        if (c > 0) {
            if (st0 <= lt) {
#pragma unroll
                for (int ks = 0; ks < 8; ++ks) {
                    const bf16x8 a = *(const LAS bf16x8*)(lds + L_CS + (lt * 32 + r) * PIT + (ks * 16 + hh * 8) * 2);
                    const bf16x8 b0 = *(const LAS bf16x8*)(lds + L_BS + (st0 * 32 + r) * PIT + (ks * 16 + hh * 8) * 2);
                    cb0 = __builtin_amdgcn_mfma_f32_32x32x16_bf16(a, b0, cb0, 0, 0, 0);
                    if (st0 + 1 <= lt) { const bf16x8 b1 = *(const LAS bf16x8*)(lds + L_BS + ((st0 + 1) * 32 + r) * PIT + (ks * 16 + hh * 8) * 2);
                        cb1 = __builtin_amdgcn_mfma_f32_32x32x16_bf16(a, b1, cb1, 0, 0, 0); }
                }
            }
        }
        __syncthreads();
        if (c > 0 && st0 <= lt) {
#pragma unroll
            for (int i = 0; i < 16; ++i) { const int l = lt * 32 + (i & 3) + 8 * (i >> 2) + 4 * hh;
                *(LAS bf16_t*)(lds + L_BS + l * PIT + (st0 * 32 + r) * 2) = (bf16_t)(cvt_pk_bf16(cb0[i], 0.f) & 0xffffu);
                if (st0 + 1 <= lt) *(LAS bf16_t*)(lds + L_BS + l * PIT + ((st0 + 1) * 32 + r) * 2) = (bf16_t)(cvt_pk_bf16(cb1[i], 0.f) & 0xffffu); }
        }
        __syncthreads();
        if (c < 16) SSD_PREFETCH(rb + 128);
        float sd0 = 0.f, sd1 = 0.f;
        if (w == 1 && c < 16) scan_load(p, rb + 128, -3, h, sd0, sd1);
        u32x2 zr[4];
        if (c > 0) {
#pragma unroll
            for (int k = 0; k < 4; ++k) zr[k] = *(const u32x2*)(proj + (size_t)(rb + lt * 32 + r) * NP + CZ + h * 64 + pt * 32 + 8 * k + 4 * hh);
        }
        f32x16 aD, aO;
#pragma unroll
        for (int i = 0; i < 16; ++i) { aD[i] = 0.f; aO[i] = 0.f; }
        if (c > 0) {
            const int lrow = lt * 32 + r; const float acl = sm[F_ACS + buf * 128 + lrow];
            for (int ks = 0; ks < 2 * (lt + 1); ++ks) {
                const int s0 = ks * 16 + hh * 8;
                const u32x4 craw = *(const LAS u32x4*)(lds + L_BS + lrow * PIT + s0 * 2);
                float cbv[8]; unpack8(craw, cbv);
                const f32x4 as0 = *(const LAS f32x4*)(sm + F_ACS + buf * 128 + s0), as1 = *(const LAS f32x4*)(sm + F_ACS + buf * 128 + s0 + 4);
                const f32x4 dt0 = *(const LAS f32x4*)(sm + F_DT + buf * 128 + s0), dt1 = *(const LAS f32x4*)(sm + F_DT + buf * 128 + s0 + 4);
                float mv[8];
#pragma unroll
                for (int j = 0; j < 8; ++j) { const float as = j < 4 ? as0[j & 3] : as1[j & 3]; const float dd = j < 4 ? dt0[j & 3] : dt1[j & 3];
                    mv[j] = (s0 + j <= lrow) ? cbv[j] * __expf(acl - as) * dd : 0.f; }
                u32x4 ap; ap.x = cvt_pk_bf16(mv[0], mv[1]); ap.y = cvt_pk_bf16(mv[2], mv[3]); ap.z = cvt_pk_bf16(mv[4], mv[5]); ap.w = cvt_pk_bf16(mv[6], mv[7]);
                const bf16x8 a = __builtin_bit_cast(bf16x8, ap);
                const bf16x8 bx = *(const LAS bf16x8*)(lds + L_XT + (pt * 32 + r) * PIT + s0 * 2);
                aD = __builtin_amdgcn_mfma_f32_32x32x16_bf16(bx, a, aD, 0, 0, 0);
            }
#pragma unroll
            for (int ks = 0; ks < 8; ++ks) {
                const bf16x8 a = *(const LAS bf16x8*)(lds + L_CS + lrow * PIT + (ks * 16 + hh * 8) * 2);
                const bf16x8 bs = *(const LAS bf16x8*)(lds + L_SB + (pt * 32 + r) * PIT + (ks * 16 + hh * 8) * 2);
                aO = __builtin_amdgcn_mfma_f32_32x32x16_bf16(bs, a, aO, 0, 0, 0);
            }
        }
        {
            const float dec = __expf(sm[F_AEND + buf]);
#pragma unroll
            for (int i = 0; i < 16; ++i) accS[i] *= dec;
#pragma unroll
            for (int ks = 0; ks < 8; ++ks) {
                const bf16x8 a = *(const LAS bf16x8*)(lds + L_XT + (pt2 * 32 + r) * PIT + (ks * 16 + hh * 8) * 2);
                const bf16x8 bb = *(const LAS bf16x8*)(lds + L_BT + (nt * 32 + r) * PIT + (ks * 16 + hh * 8) * 2);
                accS = __builtin_amdgcn_mfma_f32_32x32x16_bf16(a, bb, accS, 0, 0, 0);
            }
        }
        if (w == 1 && c < 16) scan_finish(sm, buf ^ 1, sd0, sd1, a_neg);
        if (c > 0) {
            const int l = lt * 32 + r; const float eacs = __expf(sm[F_ACS + buf * 128 + l]);
            float q = 0.f;
#pragma unroll
            for (int k = 0; k < 4; ++k) {
                const int pl = pt * 32 + 8 * k + 4 * hh;
                const float z4[4] = {bf_lo(zr[k].x), bf_hi(zr[k].x), bf_lo(zr[k].y), bf_hi(zr[k].y)};
                float gv[4];
#pragma unroll
                for (int j = 0; j < 4; ++j) { const int i = 4 * k + j;
                    const float xv = bf1(*(const LAS bf16_t*)(lds + L_XT + (pl + j) * PIT + l * 2));
                    const float y = aD[i] + eacs * aO[i] + Dh * xv;
                    gv[j] = y * silu_f(z4[j]); q += gv[j] * gv[j]; }
                u32x2 pk; pk.x = cvt_pk_bf16(gv[0], gv[1]); pk.y = cvt_pk_bf16(gv[2], gv[3]);
                *(u32x2*)(ymix + (size_t)(base + l) * KO + h * 64 + pl) = pk;
            }
            q += __shfl_xor(q, 32);
            if (hh == 0) sm[F_SSL + pt * 128 + l] = q;
        }
        __syncthreads();
        if (c > 0 && tid < 128) unsafeAtomicAdd(ssq1 + base + tid, sm[F_SSL + tid] + sm[F_SSL + 128 + tid]);
#pragma unroll
        for (int i = 0; i < 16; ++i) { const int pp = pt2 * 32 + (i & 3) + 8 * (i >> 2) + 4 * hh;
            *(LAS bf16_t*)(lds + L_SB + pp * PIT + (nt * 32 + r) * 2) = (bf16_t)(cvt_pk_bf16(accS[i], 0.f) & 0xffffu); }
    }
#undef SSD_PREFETCH
    float* so = p.out + O_SSMP + ((size_t)(b * 32 + h) * 64) * 128;
#pragma unroll
    for (int i = 0; i < 16; ++i) { const int pp = pt2 * 32 + (i & 3) + 8 * (i >> 2) + 4 * hh; so[(size_t)pp * 128 + nt * 32 + r] = accS[i]; }
    __syncthreads();
}

__device__ __forceinline__ float block_sum(float v, LAS float* red) {
    v = wave_sum(v);
    __syncthreads();
    if ((threadIdx.x & 63) == 0) red[threadIdx.x >> 6] = v;
    __syncthreads();
    float s = 0.f;
#pragma unroll
    for (int i = 0; i < 8; ++i) s += red[i];
    return s;
}

__device__ void decode_item(const Params& p, LAS unsigned char* lds, int j) {
    const int tid = threadIdx.x, lane = tid & 63, w = tid >> 6;
    const bf16_t* proj = (const bf16_t*)(p.ws + WS_PROJ);
    bf16_t* ymix = (bf16_t*)(p.ws + WS_YMIX);
    const int R = YROW_S0 + j;
    const bf16_t* prow = proj + (size_t)(ROW_S0 + j) * NP;
    LAS float* xc = (LAS float*)lds;
    LAS float* yv = xc + 3072;
    LAS float* dts = yv + 2048;
    LAS float* dAs = dts + 32;
    LAS float* red = dAs + 32;
    {
        const float* cs = p.state_ssd_conv + (size_t)j * 3 * DXBC; float* co = p.out + O_CSS + (size_t)j * 3 * DXBC;
#pragma unroll
        for (int k = 0; k < 6; ++k) { const int col = tid + 512 * k;
            const float raw = bf1(prow[CX + col]); const float s0 = cs[col], s1 = cs[DXBC + col], s2 = cs[2 * DXBC + col];
            const float a = p.conv_ssd_b[col] + p.conv_ssd_w[col] * s0 + p.conv_ssd_w[DXBC + col] * s1 + p.conv_ssd_w[2 * DXBC + col] * s2 + p.conv_ssd_w[3 * DXBC + col] * raw;
            xc[col] = silu_f(a);
            co[col] = s1; co[DXBC + col] = s2; co[2 * DXBC + col] = raw; }
        if (tid < 32) { const float d = softplus_f(bf1(prow[CDT + tid]) + p.dt_bias[tid]); dts[tid] = d; dAs[tid] = __expf(d * (-__expf(p.a_log[tid]))); }
    }
    __syncthreads();
    {
        const int g = w >> 1, q = lane & 31, half = lane >> 5;
        const f32x4 Bq = *(const LAS f32x4*)(xc + 2048 + g * 128 + 4 * q), Cq = *(const LAS f32x4*)(xc + 2560 + g * 128 + 4 * q);
        const float* sin = p.state_ssm + (size_t)j * 32 * 64 * 128; float* sout = p.out + O_SSMS + (size_t)j * 32 * 64 * 128;
        for (int hq = 0; hq < 4; ++hq) {
            const int h = 4 * w + hq; const float dtv = dts[h], dA = dAs[h], Dh = p.d_skip[h];
            for (int it0 = 0; it0 < 32; it0 += 8) {
                f32x4 sv[8];
#pragma unroll
                for (int u = 0; u < 8; ++u) { const int pp = 2 * (it0 + u) + half; sv[u] = __builtin_nontemporal_load((const f32x4*)(sin + ((size_t)h * 64 + pp) * 128 + 4 * q)); }
#pragma unroll
                for (int u = 0; u < 8; ++u) { const int pp = 2 * (it0 + u) + half; const float xv = xc[h * 64 + pp]; const float xd = xv * dtv;
                    const f32x4 sn = sv[u] * dA + Bq * xd;
                    __builtin_nontemporal_store(sn, (f32x4*)(sout + ((size_t)h * 64 + pp) * 128 + 4 * q));
                    float yp = (sn[0] * Cq[0] + sn[1] * Cq[1]) + (sn[2] * Cq[2] + sn[3] * Cq[3]);
#pragma unroll
                    for (int o = 16; o >= 1; o >>= 1) yp += __shfl_xor(yp, o);
                    if (q == 0) yv[h * 64 + pp] = yp + Dh * xv; }
            }
        }
    }
    __syncthreads();
    {
        const int c0 = tid * 4; const u32x2 zz = *(const u32x2*)(prow + CZ + c0);
        const float z[4] = {bf_lo(zz.x), bf_hi(zz.x), bf_lo(zz.y), bf_hi(zz.y)};
        float gv[4]; float ss = 0.f;
#pragma unroll
        for (int k = 0; k < 4; ++k) { gv[k] = yv[c0 + k] * silu_f(z[k]); ss += gv[k] * gv[k]; }
        const float tot = block_sum(ss, red); const float rs = __builtin_amdgcn_rsqf(tot * (1.0f / 2048.f) + EPS);
        u32x2 pk; pk.x = cvt_pk_bf16(gv[0] * rs, gv[1] * rs); pk.y = cvt_pk_bf16(gv[2] * rs, gv[3] * rs);
        *(u32x2*)(ymix + (size_t)R * KO + c0) = pk;
    }
    {
        const int c0 = tid * 4;
        const u32x2 zz = *(const u32x2*)(prow + CZS + c0), bb = *(const u32x2*)(prow + CBS + c0), cc = *(const u32x2*)(prow + CCS + c0), hh4 = *(const u32x2*)(prow + CHS + c0);
        const float z[4] = {bf_lo(zz.x), bf_hi(zz.x), bf_lo(zz.y), bf_hi(zz.y)}, bv[4] = {bf_lo(bb.x), bf_hi(bb.x), bf_lo(bb.y), bf_hi(bb.y)};
        const float cv[4] = {bf_lo(cc.x), bf_hi(cc.x), bf_lo(cc.y), bf_hi(cc.y)}, hv[4] = {bf_lo(hh4.x), bf_hi(hh4.x), bf_lo(hh4.y), bf_hi(hh4.y)};
        const float* ss_in = p.state_short_conv + (size_t)j * 2 * DM; float* so = p.out + O_SCS + (size_t)j * 2 * DM;
        const f32x4 s0 = *(const f32x4*)(ss_in + c0), s1 = *(const f32x4*)(ss_in + DM + c0);
        const f32x4 w0 = *(const f32x4*)(p.conv_sc_w + c0), w1 = *(const f32x4*)(p.conv_sc_w + DM + c0), w2 = *(const f32x4*)(p.conv_sc_w + 2 * DM + c0);
        float y[4]; f32x4 vn; float ss = 0.f;
#pragma unroll
        for (int k = 0; k < 4; ++k) { const float v = cv[k] * hv[k]; vn[k] = v; y[k] = bv[k] * (w0[k] * s0[k] + w1[k] * s1[k] + w2[k] * v) * silu_f(z[k]); ss += y[k] * y[k]; }
        *(f32x4*)(so + c0) = s1; *(f32x4*)(so + DM + c0) = vn;
        const float tot = block_sum(ss, red); const float rs = __builtin_amdgcn_rsqf(tot * (1.0f / 2048.f) + EPS);
        u32x2 pk; pk.x = cvt_pk_bf16(y[0] * rs, y[1] * rs); pk.y = cvt_pk_bf16(y[2] * rs, y[3] * rs);
        *(u32x2*)(ymix + (size_t)R * KO + 2048 + c0) = pk;
    }
    __syncthreads();
}

__device__ void sc_item(const Params& p, int item) {
    const int tid = threadIdx.x, lane = tid & 63, w = tid >> 6;
    const bf16_t* proj = (const bf16_t*)(p.ws + WS_PROJ);
    bf16_t* ymix = (bf16_t*)(p.ws + WS_YMIX);
    float* ssq2 = (float*)(p.ws + WS_SSQ2);
    const int t0 = item * 64; const int b = t0 >> 11, tpos = t0 & 2047;
    const int pr0 = t0 + NMETA * (b + 1);
    const int c0 = w * 256 + lane * 4;
    const f32x4 w0 = *(const f32x4*)(p.conv_sc_w + c0), w1 = *(const f32x4*)(p.conv_sc_w + DM + c0), w2 = *(const f32x4*)(p.conv_sc_w + 2 * DM + c0);
    f32x4 vm2, vm1;
    {
        const int g2 = pr0 - 2, g1 = pr0 - 1;
        const u32x2 c2 = *(const u32x2*)(proj + (size_t)g2 * NP + CCS + c0), h2 = *(const u32x2*)(proj + (size_t)g2 * NP + CHS + c0);
        const u32x2 c1 = *(const u32x2*)(proj + (size_t)g1 * NP + CCS + c0), h1 = *(const u32x2*)(proj + (size_t)g1 * NP + CHS + c0);
        vm2 = (f32x4){bf_lo(c2.x) * bf_lo(h2.x), bf_hi(c2.x) * bf_hi(h2.x), bf_lo(c2.y) * bf_lo(h2.y), bf_hi(c2.y) * bf_hi(h2.y)};
        vm1 = (f32x4){bf_lo(c1.x) * bf_lo(h1.x), bf_hi(c1.x) * bf_hi(h1.x), bf_lo(c1.y) * bf_lo(h1.y), bf_hi(c1.y) * bf_hi(h1.y)};
    }
    for (int i0 = 0; i0 < 64; i0 += 4) {
        u32x2 zz[4], bb[4], cc[4], hh[4];
#pragma unroll
        for (int u = 0; u < 4; ++u) { const bf16_t* pr = proj + (size_t)(pr0 + i0 + u) * NP + c0;
            zz[u] = *(const u32x2*)(pr + CZS); bb[u] = *(const u32x2*)(pr + CBS); cc[u] = *(const u32x2*)(pr + CCS); hh[u] = *(const u32x2*)(pr + CHS); }
#pragma unroll
        for (int u = 0; u < 4; ++u) { const int t = t0 + i0 + u;
            const f32x4 v = (f32x4){bf_lo(cc[u].x) * bf_lo(hh[u].x), bf_hi(cc[u].x) * bf_hi(hh[u].x), bf_lo(cc[u].y) * bf_lo(hh[u].y), bf_hi(cc[u].y) * bf_hi(hh[u].y)};
            const f32x4 z = (f32x4){bf_lo(zz[u].x), bf_hi(zz[u].x), bf_lo(zz[u].y), bf_hi(zz[u].y)};
            const f32x4 bv = (f32x4){bf_lo(bb[u].x), bf_hi(bb[u].x), bf_lo(bb[u].y), bf_hi(bb[u].y)};
            const f32x4 cv = w0 * vm2 + w1 * vm1 + w2 * v;
            f32x4 y; float ss = 0.f;
#pragma unroll
            for (int k = 0; k < 4; ++k) { y[k] = bv[k] * cv[k] * silu_f(z[k]); ss += y[k] * y[k]; }
            ss = wave_sum(ss);
            if (lane == 0) atomicAdd(ssq2 + t, ss);
            u32x2 pk; pk.x = cvt_pk_bf16(y[0], y[1]); pk.y = cvt_pk_bf16(y[2], y[3]);
            *(u32x2*)(ymix + (size_t)t * KO + 2048 + c0) = pk;
            if ((t & 2047) == 2047) { float* so = p.out + O_SCP + (size_t)b * 2 * DM; *(f32x4*)(so + c0) = vm1; *(f32x4*)(so + DM + c0) = v; }
            vm2 = vm1; vm1 = v; }
    }
    if (tpos == 2048 - 64) {
        float* co = p.out + O_CSP + (size_t)b * 3 * DXBC;
        for (int i = tid; i < 3 * DXBC; i += 512) { const int rr = i / DXBC, col = i - rr * DXBC; co[i] = bf1(proj[(size_t)(b * BROWS + NMETA + 2045 + rr) * NP + CX + col]); }
    }
}

__device__ void sample_outproj(const Params& p, LAS unsigned char* lds) {
    const int tid = threadIdx.x, lane = tid & 63, w = tid >> 6;
    const bf16_t* ymix = (const bf16_t*)(p.ws + WS_YMIX); const bf16_t* WoutT = (const bf16_t*)(p.ws + WS_WOUT);
    float* part = (float*)(p.ws + WS_SSQ4);
    const int strip = blockIdx.x >> 1, rhalf = blockIdx.x & 1; const int n0 = strip * 16;
    const int rg = w & 3, kh = w >> 2;
    const int fr = lane & 15, fq = lane >> 4;
    const bf16_t* ap = ymix + (size_t)(YROW_S0 + rhalf * 64 + rg * 16 + fr) * KO + kh * 2048 + fq * 8;
    const bf16_t* bp = WoutT + (size_t)(n0 + fr) * KO + kh * 2048 + fq * 8;
    f32x4 acc = (f32x4){0.f, 0.f, 0.f, 0.f};
    for (int ks = 0; ks < 64; ks += 16) {
        bf16x8 a[16], b[16];
#pragma unroll
        for (int u = 0; u < 16; ++u) { a[u] = *(const bf16x8*)(ap + (ks + u) * 32); b[u] = *(const bf16x8*)(bp + (ks + u) * 32); }
#pragma unroll
        for (int u = 0; u < 16; ++u) acc = __builtin_amdgcn_mfma_f32_16x16x32_bf16(a[u], b[u], acc, 0, 0, 0);
    }
    LAS f32x4* ex = (LAS f32x4*)lds;
    if (kh == 1) ex[rg * 64 + lane] = acc;
    __syncthreads();
    if (kh == 0) {
        acc += ex[rg * 64 + lane];
#pragma unroll
        for (int i = 0; i < 4; ++i) { const int srow = rhalf * 64 + rg * 16 + fq * 4 + i; const size_t o = (size_t)srow * DM + n0 + fr;
            const float v = acc[i] + p.x_sample[o]; p.out[O_YS + o] = v;
            float q = v * v;
#pragma unroll
            for (int s = 8; s >= 1; s >>= 1) q += __shfl_xor(q, s);
            if (fr == 0) part[srow * 128 + strip] = q; }
    }
    __syncthreads();
}

__device__ void p4_final(const Params& p) {
    const int tid = threadIdx.x, lane = tid & 63, wid = tid >> 6;
    const float* s3 = (const float*)(p.ws + WS_SSQ3); const float* s4 = (const float*)(p.ws + WS_SSQ4);
    const int gw = blockIdx.x * 8 + wid, nw = gridDim.x * 8;
    for (int r = gw; r < 8192 + 128; r += nw) {
        float ss; float* o;
        if (r < 8192) { ss = lane < 32 ? s3[(size_t)r * 32 + lane] : 0.f; o = p.out + O_YP + (size_t)r * DM; }
        else { const int sr = r - 8192; ss = s4[sr * 128 + lane] + s4[sr * 128 + 64 + lane]; o = p.out + O_YS + (size_t)sr * DM; }
        ss = wave_sum(ss);
        const float rs = __builtin_amdgcn_rsqf(ss * (1.0f / 2048.f) + EPS);
#pragma unroll
        for (int i = 0; i < 8; ++i) { const f32x4 v = *(const f32x4*)(o + i * 256 + lane * 4); const f32x4 wv = *(const f32x4*)(p.final_norm_w + i * 256 + lane * 4);
            *(f32x4*)(o + i * 256 + lane * 4) = v * rs * wv; }
    }
}

__global__ void __launch_bounds__(512, 2) hymba_fwd(Params p) {
    extern __shared__ __attribute__((aligned(16))) unsigned char lds_raw[];
    LAS unsigned char* lds = (LAS unsigned char*)lds_raw;
    cg::grid_group grid = cg::this_grid();
    const int lo = p.ph_lo, hi = p.ph_hi;
#ifdef ONLY
#define IN(k) ((k) == ONLY && lo <= (k) && (k) < hi)
#else
#define IN(k) (lo <= (k) && (k) < hi)
#endif
#define SEAM(k) do { if (IN(k) && IN((k) + 1)) grid.sync(); } while (0)
    if (IN(0)) p0_prep(p, lds);
    SEAM(0);
    if (IN(1)) {
        pg8::Gemm g{(const bf16_t*)(p.ws + WS_HN), (const bf16_t*)(p.ws + WS_WIN), MP, NP, DM};
        pg8::StaticOrder S; S.init(MP, NP, (int)gridDim.x, (int)blockIdx.x);
        pg8::EpiProj E{(bf16_t*)(p.ws + WS_PROJ), NP};
        pg8::gemm_phase<pg8::EpiProj>(lds, g, S, E);
    }
    SEAM(1);
    if (IN(2)) conv_pre(p);
    SEAM(2);
    if (IN(3)) {
        const int it = blockIdx.x;
        if (it < 128) { if (!(p.flags & 8)) ssd_item(p, lds, it); }
        else { if (!(p.flags & 4)) decode_item(p, lds, it - 128); if (!(p.flags & 16)) sc_item(p, it - 128); }
    }
    SEAM(3);
    if (IN(4)) {
        if (!(p.flags & 1)) sample_outproj(p, lds);
        pg8::Gemm g{(const bf16_t*)(p.ws + WS_YMIX), (const bf16_t*)(p.ws + WS_WOUT), 8192, DM, KO};
        pg8::StaticOrder S; S.init(8192, DM, (int)gridDim.x, (int)blockIdx.x);
        LAS float* tab = (LAS float*)(lds + pg8::STAGE_BYTES);
        { pg8::Unit u0; S.next(0, u0);
          if (threadIdx.x < 256) { const int r = u0.pm * 256 + threadIdx.x; const float s1 = ((const float*)(p.ws + WS_SSQ1))[r], s2 = ((const float*)(p.ws + WS_SSQ2))[r];
              const float q1 = s1 * (1.0f / 2048.f) + EPS, q2 = s2 * (1.0f / 2048.f) + EPS;
              tab[threadIdx.x] = __builtin_sqrtf(q2 / q1); tab[256 + threadIdx.x] = __builtin_amdgcn_rsqf(q2); }
          __syncthreads(); }
        pg8::EpiOut E{p.out + O_YP, p.x_prompt, tab, (float*)(p.ws + WS_SSQ3)};
        if (!(p.flags & 2)) pg8::gemm_phase<pg8::EpiOut>(lds, g, S, E);
    }
    SEAM(4);
    if (IN(5)) p4_final(p);
#undef IN
#undef SEAM
}

extern "C" void kernel_launch(void* const* d_in, const int* in_sizes, int n_in, void* d_out, int out_size, void* d_ws, size_t ws_size, hipStream_t stream) {
    static int grid = 0;
    if (grid == 0) {
        int dev = 0, cus = 0, per_cu = 0;
        hipGetDevice(&dev); hipDeviceGetAttribute(&cus, hipDeviceAttributeMultiprocessorCount, dev);
        hipFuncSetAttribute((const void*)hymba_fwd, hipFuncAttributeMaxDynamicSharedMemorySize, LDS_BYTES);
        hipOccupancyMaxActiveBlocksPerMultiprocessor(&per_cu, (const void*)hymba_fwd, 512, LDS_BYTES);
        if (per_cu < 1) per_cu = 1;
        grid = cus * 1;
        if (grid > 256) grid = 256;
        if (ws_size < WS_END) { fprintf(stderr, "workspace too small: %zu < %zu\n", ws_size, (size_t)WS_END); }
    }
    Params p{};
    p.x_prompt = (const float*)d_in[0]; p.x_sample = (const float*)d_in[1]; p.state_ssm = (const float*)d_in[2]; p.state_ssd_conv = (const float*)d_in[3];
    p.state_short_conv = (const float*)d_in[4]; p.meta = (const float*)d_in[5]; p.norm_w = (const float*)d_in[6]; p.w_in = (const float*)d_in[7];
    p.conv_ssd_w = (const float*)d_in[8]; p.conv_ssd_b = (const float*)d_in[9]; p.dt_bias = (const float*)d_in[10]; p.a_log = (const float*)d_in[11];
    p.d_skip = (const float*)d_in[12]; p.ssd_norm_w = (const float*)d_in[13]; p.conv_sc_w = (const float*)d_in[14]; p.sc_norm_w = (const float*)d_in[15];
    p.w_out = (const float*)d_in[16]; p.final_norm_w = (const float*)d_in[17];
    p.out = (float*)d_out; p.ws = (unsigned char*)d_ws;
#if N_LAUNCH == 1
    p.ph_lo = 0; p.ph_hi = 6;
    void* args[] = {&p};
    hipError_t e = hipLaunchCooperativeKernel((const void*)hymba_fwd, dim3(grid), dim3(512), args, LDS_BYTES, stream);
    if (e != hipSuccess) fprintf(stderr, "cooperative launch failed: %s (grid %d)\n", hipGetErrorString(e), grid);
#else
    const int sched[][3] = {SCHED};
    for (unsigned li = 0; li < sizeof(sched) / sizeof(sched[0]); ++li) {
        p.ph_lo = sched[li][0]; p.ph_hi = sched[li][1]; p.flags = sched[li][2];
        void* args[] = {&p};
        hipError_t e = hipLaunchCooperativeKernel((const void*)hymba_fwd, dim3(grid), dim3(512), args, LDS_BYTES, stream);
        if (e != hipSuccess) fprintf(stderr, "cooperative launch failed: %s (grid %d)\n", hipGetErrorString(e), grid);
    }
#endif
}
```

```cpp
#include <hip/hip_runtime.h>
#include <hip/hip_cooperative_groups.h>
#include <cstdio>
namespace cg = cooperative_groups;

#define LAS __attribute__((address_space(3)))
typedef unsigned short bf16_t;
typedef short bf16x8 __attribute__((ext_vector_type(8)));
typedef float f32x4 __attribute__((ext_vector_type(4)));
typedef float f32x16 __attribute__((ext_vector_type(16)));
typedef unsigned u32x4 __attribute__((ext_vector_type(4)));
typedef unsigned u32x2 __attribute__((ext_vector_type(2)));

#ifndef N_LAUNCH
#define N_LAUNCH 1
#endif
#define REP0 1
#define REP1 1
#define REP3 1
#define SCHED {0,6,0}

constexpr int DM = 2048;
constexpr int SEQ = 2048, NB = 4, NS = 128, NMETA = 16;
constexpr int NPROJ = 13344;
constexpr int NP = 13568;
constexpr int MP = 8448;
constexpr int BROWS = 2064;
constexpr int ROW_S0 = 8256;
constexpr int ROW_END = 8384;
constexpr int YROW_S0 = 8192;
constexpr int DXBC = 3072;
constexpr int CZ = 0, CX = 2048, CBm = 4096, CCm = 4608, CZS = 5120, CBS = 7168, CCS = 9216, CHS = 11264, CDT = 13312;
constexpr int KO = 4096;
constexpr float EPS = 1e-5f;

constexpr size_t O_YP = 0;
constexpr size_t O_YS = O_YP + (size_t)NB * SEQ * DM;
constexpr size_t O_SSMP = O_YS + (size_t)NS * DM;
constexpr size_t O_CSP = O_SSMP + (size_t)NB * 32 * 64 * 128;
constexpr size_t O_SCP = O_CSP + (size_t)NB * 3 * DXBC;
constexpr size_t O_SSMS = O_SCP + (size_t)NB * 2 * DM;
constexpr size_t O_CSS = O_SSMS + (size_t)NS * 32 * 64 * 128;
constexpr size_t O_SCS = O_CSS + (size_t)NS * 3 * DXBC;

constexpr size_t WS_WIN = 0;
constexpr size_t WS_WOUT = WS_WIN + (size_t)NP * DM * 2;
constexpr size_t WS_HN = WS_WOUT + (size_t)DM * KO * 2;
constexpr size_t WS_PROJ = WS_HN + (size_t)MP * DM * 2;
constexpr size_t WS_YMIX = WS_PROJ + (size_t)MP * NP * 2;
constexpr size_t WS_SSQ1 = WS_YMIX + (size_t)MP * KO * 2;
constexpr size_t WS_SSQ2 = WS_SSQ1 + (size_t)MP * 4;
constexpr size_t WS_SSQ3 = WS_SSQ2 + (size_t)MP * 4;
constexpr size_t WS_SSQ4 = WS_SSQ3 + (size_t)8192 * 32 * 4;
constexpr size_t WS_XC = WS_SSQ4 + (size_t)128 * 128 * 4;
constexpr size_t WS_DTV = WS_XC + (size_t)MP * DXBC * 2;
constexpr size_t WS_BAR = WS_DTV + (size_t)MP * 32 * 4;
constexpr size_t WS_END = WS_BAR + 16384;

constexpr int LDS_BYTES = 147456;

struct Params {
    const float* x_prompt; const float* x_sample; const float* state_ssm; const float* state_ssd_conv; const float* state_short_conv;
    const float* meta; const float* norm_w; const float* w_in; const float* conv_ssd_w; const float* conv_ssd_b; const float* dt_bias;
    const float* a_log; const float* d_skip; const float* ssd_norm_w; const float* conv_sc_w; const float* sc_norm_w; const float* w_out;
    const float* final_norm_w;
    float* out; unsigned char* ws;
    int ph_lo, ph_hi, flags, pad;
};

__device__ __forceinline__ unsigned cvt_pk_bf16(float lo, float hi) { unsigned r; asm("v_cvt_pk_bf16_f32 %0, %1, %2" : "=v"(r) : "v"(lo), "v"(hi)); return r; }
__device__ __forceinline__ float bf_lo(unsigned u) { return __uint_as_float(u << 16); }
__device__ __forceinline__ float bf_hi(unsigned u) { return __uint_as_float(u & 0xffff0000u); }
__device__ __forceinline__ float bf1(bf16_t u) { return __uint_as_float(((unsigned)u) << 16); }
__device__ __forceinline__ float silu_f(float x) { return x * __builtin_amdgcn_rcpf(1.0f + __expf(-x)); }
__device__ __forceinline__ float softplus_f(float x) { return x > 20.f ? x : log1pf(__expf(x)); }
__device__ __forceinline__ float wave_sum(float v) {
#pragma unroll
    for (int o = 32; o >= 1; o >>= 1) v += __shfl_xor(v, o);
    return v;
}
__device__ __forceinline__ void unpack8(const u32x4 u, float (&f)[8]) {
    f[0] = bf_lo(u.x); f[1] = bf_hi(u.x); f[2] = bf_lo(u.y); f[3] = bf_hi(u.y); f[4] = bf_lo(u.z); f[5] = bf_hi(u.z); f[6] = bf_lo(u.w); f[7] = bf_hi(u.w);
}

namespace pg8 {
constexpr int BM = 256, BK = 64, HALF = 128, HTB = HALF * BK * 2, STAGE_BYTES = 8 * HTB, NXCD = 8, WGM = 8;
__device__ __forceinline__ int lds_byte(int r, int c) { const int st = (r >> 4) * 2 + (c >> 5), rr = r & 15, cc = c & 31, ob = rr * 64 + cc * 2; return st * 1024 + (ob ^ (((ob >> 9) & 1) << 5)); }
__device__ __forceinline__ void stage_rc(int b, int& R, int& C) { const int st = b / 1024, sb = b % 1024, swz = sb ^ (((sb >> 9) & 1) << 5); R = (st >> 1) * 16 + swz / 64; C = (st & 1) * 32 + (swz % 64) / 2; }
__device__ __forceinline__ int perm32(int rho) { const int n = rho >> 4, i = rho & 15; return 8 * (i >> 2) + 4 * n + (i & 3); }
struct Unit { int pm, pn; };
struct Gemm { const bf16_t* A; const bf16_t* Bt; int M, N, K; };
struct StaticOrder {
    int nM, nN, nwg, G, c;
    __device__ void init(int M, int N, int G_, int c_) { nM = M / BM; nN = N / BM; nwg = nM * nN; G = G_; c = c_; }
    __device__ bool next(int i, Unit& u) const {
        const long L = (long)i * G + c; if (L >= nwg) return false;
        int wgid = (int)L; { const int q = nwg / NXCD, r = nwg % NXCD, xcd = wgid % NXCD, off = wgid / NXCD; wgid = (xcd < r ? xcd * (q + 1) : r * (q + 1) + (xcd - r) * q) + off; }
        const int nig = WGM * nN, gid = wgid / nig, fm = gid * WGM, gsz = (nM - fm) < WGM ? (nM - fm) : WGM;
        u.pm = fm + ((wgid % nig) % gsz); u.pn = (wgid % nig) / gsz; return true;
    }
};

struct EpiProj {
    static constexpr bool PERM = true, MID = false;
    bf16_t* O; int ldc;
    __device__ __forceinline__ void mid(f32x4 (&acc)[2][2][4][2], const Unit& u, int wr, int wc, int fr, int fq) const {}
    __device__ __forceinline__ void operator()(const f32x4 (&acc)[2][2][4][2], const Unit& u, int wr, int wc, int fr, int fq) const {
        const int row0 = u.pm * BM + wr * 64 + fr; const int col0 = u.pn * BM + wc * 32 + 8 * fq;
#pragma unroll
        for (int ai = 0; ai < 2; ++ai)
#pragma unroll
            for (int m = 0; m < 4; ++m) { bf16_t* rowp = O + (size_t)(row0 + ai * HALF + m * 16) * ldc + col0;
#pragma unroll
                for (int bj = 0; bj < 2; ++bj) { const f32x4 v0 = acc[ai][bj][m][0], v1 = acc[ai][bj][m][1];
                    u32x4 w; w.x = cvt_pk_bf16(v0[0], v0[1]); w.y = cvt_pk_bf16(v0[2], v0[3]); w.z = cvt_pk_bf16(v1[0], v1[1]); w.w = cvt_pk_bf16(v1[2], v1[3]);
                    *(u32x4*)(rowp + bj * HALF) = w; } }
    }
};
struct EpiOut {
    static constexpr bool PERM = false, MID = true;
    float* C; LAS const float* tab;
    __device__ __forceinline__ void mid(f32x4 (&acc)[2][2][4][2], const Unit& u, int wr, int wc, int fr, int fq) const {
#pragma unroll
        for (int ai = 0; ai < 2; ++ai)
#pragma unroll
            for (int m = 0; m < 4; ++m) { const float f = tab[wr * 64 + fr + ai * HALF + m * 16];
#pragma unroll
                for (int bj = 0; bj < 2; ++bj)
#pragma unroll
                    for (int n = 0; n < 2; ++n) acc[ai][bj][m][n] *= f; }
    }
    __device__ __forceinline__ void operator()(const f32x4 (&acc)[2][2][4][2], const Unit& u, int wr, int wc, int fr, int fq) const {
        const int row0 = u.pm * BM + wr * 64 + fr, col0 = u.pn * BM + wc * 32 + 4 * fq;
#pragma unroll
        for (int ai = 0; ai < 2; ++ai)
#pragma unroll
            for (int m = 0; m < 4; ++m) { const int r = row0 + ai * HALF + m * 16;
                const float rs = tab[256 + wr * 64 + fr + ai * HALF + m * 16];
                float* rowp = C + (size_t)r * DM + col0;
#pragma unroll
                for (int bj = 0; bj < 2; ++bj)
#pragma unroll
                    for (int n = 0; n < 2; ++n) *(f32x4*)(rowp + bj * HALF + n * 16) = acc[ai][bj][m][n] * rs; }
    }
};

template <class Epi>
__device__ __forceinline__ void gemm_phase(LAS unsigned char* lds, const Gemm g, const StaticOrder& S, const Epi& E) {
    const int tid = threadIdx.x, wid = __builtin_amdgcn_readfirstlane(tid >> 6), lane = tid & 63, wr = wid >> 2, wc = wid & 3, fr = lane & 15, fq = lane >> 4;
    const int K = g.K, nt = K / BK;
    unsigned voffA[2], voffB[2];
#pragma unroll
    for (int i = 0; i < 2; ++i) { int R, C; stage_rc(tid * 16 + i * 8192, R, C); const int Rb = Epi::PERM ? ((R & ~31) + perm32(R & 31)) : R;
        voffA[i] = (unsigned)(R * K + C) * 2u; voffB[i] = (unsigned)(Rb * K + C) * 2u; }
    const size_t kstep = (size_t)(BK * 2);
    const size_t hstep = (size_t)HALF * K * 2;
    const size_t tstep = 2 * hstep;
    const unsigned ldsw = (unsigned)wid * 1024u;
    const int aoff = lds_byte(wr * 64 + fr, fq * 8), boff = lds_byte(wc * 32 + fr, fq * 8);
#define PG8_SA(b, h) (((b) * 2 + (h)) * HTB)
#define PG8_SB(b, h) ((4 + (b) * 2 + (h)) * HTB)
#define PG8_STAGE(bufoff, gbase, voff) do { _Pragma("unroll") for (int _i = 0; _i < 2; ++_i) \
        __builtin_amdgcn_global_load_lds((const unsigned*)((const char*)(gbase) + (voff)[_i]), (LAS unsigned*)(lds + (bufoff) + ldsw + _i * 8192), 16, 0, 0); } while (0)
#define PG8_LDA(dst, b, h) do { _Pragma("unroll") for (int m = 0; m < 4; ++m) _Pragma("unroll") for (int k = 0; k < 2; ++k) dst[m][k] = *(const LAS bf16x8*)(lds + PG8_SA(b, h) + aoff + m * 2048 + k * 1024); } while (0)
#define PG8_LDB(dst, b, h) do { _Pragma("unroll") for (int n = 0; n < 2; ++n) _Pragma("unroll") for (int k = 0; k < 2; ++k) dst[n][k] = *(const LAS bf16x8*)(lds + PG8_SB(b, h) + boff + n * 2048 + k * 1024); } while (0)
#define PG8_MMA(ai, bj, At, Bt) do { __builtin_amdgcn_s_setprio(1); _Pragma("unroll") for (int m = 0; m < 4; ++m) _Pragma("unroll") for (int n = 0; n < 2; ++n) _Pragma("unroll") for (int k = 0; k < 2; ++k) \
        acc[ai][bj][m][n] = __builtin_amdgcn_mfma_f32_16x16x32_bf16(Bt[n][k], At[m][k], acc[ai][bj][m][n], 0, 0, 0); __builtin_amdgcn_s_setprio(0); } while (0)
#define PG8_WAIT_V(n) asm volatile("s_waitcnt vmcnt(" #n ")" ::: "memory")
#define PG8_WAIT_L(n) asm volatile("s_waitcnt lgkmcnt(" #n ")" ::: "memory")
#define PG8_BAR __builtin_amdgcn_s_barrier()
#define PG8_SCHED __builtin_amdgcn_sched_barrier(0)
    Unit cur, nxt; int ui = 0;
    if (!S.next(0, cur)) return;
    f32x4 acc[2][2][4][2];
#pragma unroll
    for (int a = 0; a < 2; ++a)
#pragma unroll
        for (int b = 0; b < 2; ++b)
#pragma unroll
            for (int m = 0; m < 4; ++m)
#pragma unroll
                for (int n = 0; n < 2; ++n) acc[a][b][m][n] = (f32x4){0.f, 0.f, 0.f, 0.f};
    bf16x8 At[4][2], B0[2][2], B1[2][2];
    const char* cA = (const char*)g.A + (size_t)cur.pm * tstep; const char* cB = (const char*)g.Bt + (size_t)cur.pn * tstep;
    PG8_STAGE(PG8_SB(0, 0), cB, voffB); PG8_STAGE(PG8_SA(0, 0), cA, voffA); PG8_STAGE(PG8_SB(0, 1), cB + hstep, voffB); PG8_STAGE(PG8_SA(0, 1), cA + hstep, voffA);
    if (wr == 1) PG8_BAR;
    PG8_WAIT_V(4); PG8_BAR;
    PG8_STAGE(PG8_SB(1, 0), cB + kstep, voffB); PG8_STAGE(PG8_SA(1, 0), cA + kstep, voffA); PG8_STAGE(PG8_SB(1, 1), cB + hstep + kstep, voffB);
    PG8_WAIT_V(6); PG8_BAR;
    for (;;) {
        const bool has_next = S.next(ui + 1, nxt);
        const char* nA = has_next ? (const char*)g.A + (size_t)nxt.pm * tstep : cA; const char* nB = has_next ? (const char*)g.Bt + (size_t)nxt.pn * tstep : cB;
        for (int t = 0; t < nt; t += 2) {
            const bool last = (t == nt - 2);
            const char* a1 = cA + (size_t)(t + 1) * kstep;
            const char* a2 = last ? nA : cA + (size_t)(t + 2) * kstep; const char* b2 = last ? nB : cB + (size_t)(t + 2) * kstep;
            const char* a3 = a2 + kstep; const char* b3 = b2 + kstep;
            if constexpr (Epi::MID) { if (t == (nt >> 1)) E.mid(acc, cur, wr, wc, fr, fq); }
            PG8_LDB(B0, 0, 0); PG8_SCHED; PG8_LDA(At, 0, 0); PG8_STAGE(PG8_SA(1, 1), a1 + hstep, voffA);
            PG8_WAIT_L(8); PG8_BAR; PG8_WAIT_L(0); PG8_MMA(0, 0, At, B0); PG8_BAR; PG8_SCHED;
            PG8_LDB(B1, 0, 1); PG8_STAGE(PG8_SB(0, 0), b2, voffB);
            PG8_BAR; PG8_WAIT_L(0); PG8_MMA(0, 1, At, B1); PG8_BAR;
            PG8_LDA(At, 0, 1); PG8_STAGE(PG8_SA(0, 0), a2, voffA);
            PG8_BAR; PG8_WAIT_L(0); PG8_MMA(1, 0, At, B0); PG8_BAR; PG8_SCHED;
            PG8_STAGE(PG8_SB(0, 1), b2 + hstep, voffB);
            PG8_WAIT_V(6); PG8_BAR; PG8_MMA(1, 1, At, B1); PG8_BAR;
            PG8_LDB(B0, 1, 0); PG8_SCHED; PG8_LDA(At, 1, 0); PG8_STAGE(PG8_SA(0, 1), a2 + hstep, voffA);
            PG8_WAIT_L(8); PG8_BAR; PG8_WAIT_L(0); PG8_MMA(0, 0, At, B0); PG8_BAR; PG8_SCHED;
            PG8_LDB(B1, 1, 1); PG8_STAGE(PG8_SB(1, 0), b3, voffB);
            PG8_BAR; PG8_WAIT_L(0); PG8_MMA(0, 1, At, B1); PG8_BAR;
            PG8_LDA(At, 1, 1); PG8_STAGE(PG8_SA(1, 0), a3, voffA);
            PG8_BAR; PG8_WAIT_L(0); PG8_MMA(1, 0, At, B0); PG8_BAR; PG8_SCHED;
            PG8_STAGE(PG8_SB(1, 1), b3 + hstep, voffB);
            PG8_WAIT_V(6); PG8_BAR; PG8_MMA(1, 1, At, B1); PG8_BAR;
        }
        E(acc, cur, wr, wc, fr, fq);
        if (!has_next) break;
#pragma unroll
        for (int a = 0; a < 2; ++a)
#pragma unroll
            for (int b = 0; b < 2; ++b)
#pragma unroll
                for (int m = 0; m < 4; ++m)
#pragma unroll
                    for (int n = 0; n < 2; ++n) acc[a][b][m][n] = (f32x4){0.f, 0.f, 0.f, 0.f};
        cur = nxt; cA = nA; cB = nB; ++ui;
    }
    PG8_WAIT_V(0);
    if (wr == 0) PG8_BAR;
    PG8_BAR;
#undef PG8_SA
#undef PG8_SB
#undef PG8_STAGE
#undef PG8_LDA
#undef PG8_LDB
#undef PG8_MMA
#undef PG8_WAIT_V
#undef PG8_WAIT_L
#undef PG8_BAR
#undef PG8_SCHED
}
}

struct TrTile { const float* src; int spitch, scol0, nvalid, k0; bf16_t* dst; int dpitch, n0; const float* sc0; const float* sc1; };
__device__ __forceinline__ TrTile tr_desc(const Params& p, int t) {
    constexpr int T_IN = 212 * 16;
    TrTile d;
    if (t < T_IN) {
        const int nt_ = t >> 4, kt = t & 15; const int n0 = nt_ * 64;
        int scol, nvalid;
        if (n0 < 5120) { scol = n0; nvalid = 64; }
        else if (n0 < 13312) { scol = n0 + 32; nvalid = 64; }
        else if (n0 == 13312) { scol = 5120; nvalid = 32; }
        else { scol = 0; nvalid = 0; }
        d.src = p.w_in; d.spitch = NPROJ; d.scol0 = scol; d.nvalid = nvalid; d.k0 = kt * 128; d.dst = (bf16_t*)(p.ws + WS_WIN); d.dpitch = DM; d.n0 = n0; d.sc0 = nullptr; d.sc1 = nullptr;
    } else {
        const int tt = t - T_IN; const int nt_ = tt >> 5, kt = tt & 31;
        d.src = p.w_out; d.spitch = DM; d.scol0 = nt_ * 64; d.nvalid = 64; d.k0 = kt * 128; d.dst = (bf16_t*)(p.ws + WS_WOUT); d.dpitch = KO; d.n0 = nt_ * 64; d.sc0 = p.ssd_norm_w; d.sc1 = p.sc_norm_w;
    }
    return d;
}
__device__ __forceinline__ void tr_load(const TrTile& d, f32x4 (&r)[2][2], float (&sc)[2][2]) {
    const int tid = threadIdx.x, nq = tid & 15, kp = tid >> 4;
#pragma unroll
    for (int pass = 0; pass < 2; ++pass) {
        const int kg = d.k0 + pass * 64 + kp * 2;
        r[pass][0] = (f32x4){0.f, 0.f, 0.f, 0.f}; r[pass][1] = r[pass][0];
        if (nq * 4 < d.nvalid) {
            r[pass][0] = __builtin_nontemporal_load((const f32x4*)(d.src + (size_t)kg * d.spitch + d.scol0 + nq * 4));
            r[pass][1] = __builtin_nontemporal_load((const f32x4*)(d.src + (size_t)(kg + 1) * d.spitch + d.scol0 + nq * 4));
        }
        sc[pass][0] = 1.f; sc[pass][1] = 1.f;
        if (d.sc0) { sc[pass][0] = (kg < 2048) ? d.sc0[kg] : d.sc1[kg - 2048]; sc[pass][1] = (kg + 1 < 2048) ? d.sc0[kg + 1] : d.sc1[kg + 1 - 2048]; }
    }
}
__device__ __forceinline__ void tr_store(LAS unsigned char* lds, const TrTile& d, const f32x4 (&r)[2][2], const float (&sc)[2][2]) {
    const int tid = threadIdx.x, nq = tid & 15, kp = tid >> 4;
    LAS unsigned* T = (LAS unsigned*)lds;
#pragma unroll
    for (int pass = 0; pass < 2; ++pass)
#pragma unroll
        for (int j = 0; j < 4; ++j) T[(nq * 4 + j) * 68 + pass * 32 + kp] = cvt_pk_bf16(r[pass][0][j] * sc[pass][0], r[pass][1][j] * sc[pass][1]);
    __syncthreads();
#pragma unroll
    for (int i = 0; i < 2; ++i) {
        const int ch = tid + i * 512; const int n = ch >> 4, c16 = ch & 15;
        const u32x4 v = *(const LAS u32x4*)(T + n * 68 + c16 * 4);
        *(u32x4*)(d.dst + (size_t)(d.n0 + n) * d.dpitch + d.k0 + c16 * 8) = v;
    }
    __syncthreads();
}

__device__ void p0_prep(const Params& p, LAS unsigned char* lds) {
    const int tid = threadIdx.x, lane = tid & 63, wid = tid >> 6;
    bf16_t* hn = (bf16_t*)(p.ws + WS_HN);
    { float* s1 = (float*)(p.ws + WS_SSQ1); for (int i = blockIdx.x * 512 + tid; i < 2 * MP; i += gridDim.x * 512) s1[i] = 0.f; }
    constexpr int T_ALL = 212 * 16 + 32 * 32;
    {
        int t = blockIdx.x;
        TrTile dc = tr_desc(p, t < T_ALL ? t : 0);
        f32x4 rc[2][2]; float sc[2][2];
        if (t < T_ALL) tr_load(dc, rc, sc);
        while (t < T_ALL) {
            const int tn = t + gridDim.x;
            TrTile dn = tr_desc(p, tn < T_ALL ? tn : 0);
            f32x4 rn[2][2]; float sn[2][2];
            if (tn < T_ALL) tr_load(dn, rn, sn);
            tr_store(lds, dc, rc, sc);
            dc = dn; t = tn;
#pragma unroll
            for (int a = 0; a < 2; ++a)
#pragma unroll
                for (int b = 0; b < 2; ++b) { rc[a][b] = rn[a][b]; sc[a][b] = sn[a][b]; }
        }
    }
    const int gw = blockIdx.x * 8 + wid, nw = gridDim.x * 8;
    for (int r = gw; r < MP; r += nw) {
        bf16_t* o = hn + (size_t)r * DM;
        if (r >= ROW_END) {
#pragma unroll
            for (int i = 0; i < 8; ++i) *(u32x2*)(o + i * 256 + lane * 4) = (u32x2){0u, 0u};
            continue;
        }
        const float* src;
        if (r < ROW_S0) { const int bb = r / BROWS, q = r - bb * BROWS; src = q < NMETA ? p.meta + (size_t)q * DM : p.x_prompt + ((size_t)bb * SEQ + (q - NMETA)) * DM; }
        else src = p.x_sample + (size_t)(r - ROW_S0) * DM;
        f32x4 v[8]; float ss = 0.f;
#pragma unroll
        for (int i = 0; i < 8; ++i) { v[i] = *(const f32x4*)(src + i * 256 + lane * 4); ss += (v[i][0] * v[i][0] + v[i][1] * v[i][1]) + (v[i][2] * v[i][2] + v[i][3] * v[i][3]); }
        ss = wave_sum(ss);
        const float rs = __builtin_amdgcn_rsqf(ss * (1.0f / 2048.f) + EPS);
#pragma unroll
        for (int i = 0; i < 8; ++i) { const f32x4 w = *(const f32x4*)(p.norm_w + i * 256 + lane * 4);
            u32x2 pk; pk.x = cvt_pk_bf16(v[i][0] * rs * w[0], v[i][1] * rs * w[1]); pk.y = cvt_pk_bf16(v[i][2] * rs * w[2], v[i][3] * rs * w[3]);
            *(u32x2*)(o + i * 256 + lane * 4) = pk; }
    }
}

constexpr int PIT = 272;
constexpr int L_CS = 0, L_BS = 34816, L_BT = 69632, L_XT = 104448, L_SB = 121856, L_SC = 139264;
constexpr int F_DT = 0, F_ACS = 256, F_WV = 512, F_SSL = 768, F_AEND = 1024;

__device__ __forceinline__ void scan_load(const Params& p, int rb, int lmin, int h, float& d0, float& d1) {
    const int lane = threadIdx.x & 63; const float* dtv = (const float*)(p.ws + WS_DTV);
    const int l0 = 2 * lane, g0 = max(rb + l0, 0), g1 = max(rb + l0 + 1, 0);
    d0 = dtv[g0 * 32 + h]; d1 = dtv[g1 * 32 + h];
    d0 = l0 >= lmin ? d0 : 0.f; d1 = l0 + 1 >= lmin ? d1 : 0.f;
}
__device__ __forceinline__ void scan_finish(LAS float* sm, int buf, float d0, float d1, float a_neg) {
    const int lane = threadIdx.x & 63;
    const float x0 = d0 * a_neg, x1 = d1 * a_neg;
    float s = x0 + x1;
#pragma unroll
    for (int o = 1; o < 64; o <<= 1) { const float t = __shfl_up(s, o); if (lane >= o) s += t; }
    const float c1 = s, c0 = s - x1;
    const float aend = __shfl(s, 63);
    sm[F_DT + buf * 128 + 2 * lane] = d0; sm[F_DT + buf * 128 + 2 * lane + 1] = d1;
    sm[F_ACS + buf * 128 + 2 * lane] = c0; sm[F_ACS + buf * 128 + 2 * lane + 1] = c1;
    sm[F_WV + buf * 128 + 2 * lane] = d0 * __expf(aend - c0); sm[F_WV + buf * 128 + 2 * lane + 1] = d1 * __expf(aend - c1);
    if (lane == 0) sm[F_AEND + buf] = aend;
}

template <int NR, class Store>
__device__ __forceinline__ void conv_rows(const Params& p, int rb, int lmin, int l0, int pcol, int wcol, Store&& st) {
    const bf16_t* proj = (const bf16_t*)(p.ws + WS_PROJ);
    u32x4 raw[NR + 3];
#pragma unroll
    for (int i = 0; i < NR + 3; ++i) { const int l = l0 - 3 + i; const int g = max(rb + l, 0);
        raw[i] = *(const u32x4*)(proj + (size_t)g * NP + pcol);
        if (l < lmin) raw[i] = (u32x4){0u, 0u, 0u, 0u}; }
    float w[4][8], bias[8];
#pragma unroll
    for (int k = 0; k < 4; ++k) { const f32x4 a = *(const f32x4*)(p.conv_ssd_w + k * DXBC + wcol), b = *(const f32x4*)(p.conv_ssd_w + k * DXBC + wcol + 4);
        w[k][0] = a[0]; w[k][1] = a[1]; w[k][2] = a[2]; w[k][3] = a[3]; w[k][4] = b[0]; w[k][5] = b[1]; w[k][6] = b[2]; w[k][7] = b[3]; }
    { const f32x4 a = *(const f32x4*)(p.conv_ssd_b + wcol), b = *(const f32x4*)(p.conv_ssd_b + wcol + 4);
      bias[0] = a[0]; bias[1] = a[1]; bias[2] = a[2]; bias[3] = a[3]; bias[4] = b[0]; bias[5] = b[1]; bias[6] = b[2]; bias[7] = b[3]; }
    float h0[8], h1[8], h2[8], cur[8];
    unpack8(raw[0], h0); unpack8(raw[1], h1); unpack8(raw[2], h2);
#pragma unroll
    for (int i = 0; i < NR; ++i) {
        unpack8(raw[i + 3], cur);
        float o[8];
#pragma unroll
        for (int j = 0; j < 8; ++j) { const float a = bias[j] + w[0][j] * h0[j] + w[1][j] * h1[j] + w[2][j] * h2[j] + w[3][j] * cur[j]; o[j] = silu_f(a); }
        st(i, o);
#pragma unroll
        for (int j = 0; j < 8; ++j) { h0[j] = h1[j]; h1[j] = h2[j]; h2[j] = cur[j]; }
    }
}

__device__ void conv_pre(const Params& p) {
    const bf16_t* proj = (const bf16_t*)(p.ws + WS_PROJ);
    bf16_t* xc = (bf16_t*)(p.ws + WS_XC); float* dtv = (float*)(p.ws + WS_DTV);
    const int gt = blockIdx.x * 512 + threadIdx.x, nthr = gridDim.x * 512;
    for (int T = gt; T < (ROW_S0 / 4) * 384; T += nthr) {
        const int cgp = T % 384, rg = T / 384; const int R0 = rg * 4, col = cgp * 8;
        const int lmin = (R0 % BROWS) != 0 ? -3 : 0;
        conv_rows<4>(p, R0, lmin, 0, CX + col, col, [&](int i, const float (&o)[8]) {
            u32x4 pk; pk.x = cvt_pk_bf16(o[0], o[1]); pk.y = cvt_pk_bf16(o[2], o[3]); pk.z = cvt_pk_bf16(o[4], o[5]); pk.w = cvt_pk_bf16(o[6], o[7]);
            *(u32x4*)(xc + (size_t)(R0 + i) * DXBC + col) = pk; });
    }
    for (int T = gt; T < ROW_S0 * 32; T += nthr) { const int R = T >> 5, h = T & 31; dtv[T] = softplus_f(bf1(proj[(size_t)R * NP + CDT + h]) + p.dt_bias[h]); }
}

__device__ void ssd_item(const Params& p, LAS unsigned char* lds, int item) {
    const int tid = threadIdx.x, lane = tid & 63, w = __builtin_amdgcn_readfirstlane(tid >> 6), r = lane & 31, hh = lane >> 5;
    const int pair = (item & 7) + 8 * (item >> 6), hg = (item >> 3) & 7;
    const int b = pair >> 2, g = pair & 3, h = g * 8 + hg;
    const bf16_t* proj = (const bf16_t*)(p.ws + WS_PROJ);
    const bf16_t* xc = (const bf16_t*)(p.ws + WS_XC);
    bf16_t* ymix = (bf16_t*)(p.ws + WS_YMIX);
    float* ssq1 = (float*)(p.ws + WS_SSQ1);
    LAS float* sm = (LAS float*)(lds + L_SC);
    const float a_neg = -__expf(p.a_log[h]), Dh = p.d_skip[h];
    const int l0 = (((tid >> 2) & 3) | ((tid >> 6) << 2)) * 4, n0 = ((tid & 3) | (((tid >> 4) & 3) << 2)) * 8; const int xl0 = (tid >> 3) * 2, p0 = (tid & 7) * 8;
    const int colB = 2048 + g * 128 + n0, colC = colB + 512, colX = h * 64 + p0;
    u32x4 pB[4], pC[4], pX[2];
#define SSD_PREFETCH(RB) do { \
        _Pragma("unroll") for (int i = 0; i < 4; ++i) { const size_t gg = (size_t)max((RB) + l0 + i, 0) * DXBC; pB[i] = *(const u32x4*)(xc + gg + colB); pC[i] = *(const u32x4*)(xc + gg + colC); } \
        _Pragma("unroll") for (int i = 0; i < 2; ++i) { const size_t gg = (size_t)max((RB) + xl0 + i, 0) * DXBC; pX[i] = *(const u32x4*)(xc + gg + colX); } } while (0)
    SSD_PREFETCH(b * BROWS - 112);
    for (int i = tid; i < 17408 / 4; i += 512) ((LAS unsigned*)(lds + L_SB))[i] = 0u;
    if (w == 1) { float d0, d1; scan_load(p, b * BROWS - 112, 112, h, d0, d1); scan_finish(sm, 0, d0, d1, a_neg); }
    f32x16 accS;
#pragma unroll
    for (int i = 0; i < 16; ++i) accS[i] = 0.f;
    const int lt = w < 4 ? (w >> 1) : 3 - ((w - 4) >> 1), pt = w & 1, pt2 = w >> 2, nt = w & 3;
    __syncthreads();
    for (int c = 0; c <= 16; ++c) {
        const int buf = c & 1; const int rb = b * BROWS + NMETA + (c - 1) * 128, lmin = (c == 0) ? 112 : -3; const int base = b * SEQ + (c - 1) * 128;
        {
            unsigned bt[8][2], xt[8];
#pragma unroll
            for (int i = 0; i < 4; ++i) {
                const bool valid = (l0 + i) >= lmin;
                const u32x4 vb = valid ? pB[i] : (u32x4){0u, 0u, 0u, 0u}, vc = valid ? pC[i] : (u32x4){0u, 0u, 0u, 0u};
                *(LAS u32x4*)(lds + L_BS + (l0 + i) * PIT + n0 * 2) = vb;
                *(LAS u32x4*)(lds + L_CS + (l0 + i) * PIT + n0 * 2) = vc;
                float f[8]; unpack8(vb, f);
                const float wl = sm[F_WV + buf * 128 + l0 + i];
#pragma unroll
                for (int j = 0; j < 8; ++j) { const unsigned q = cvt_pk_bf16(f[j] * wl, 0.f);
                    if (i & 1) bt[j][i >> 1] |= q << 16; else bt[j][i >> 1] = q & 0xffffu; }
            }
#pragma unroll
            for (int j = 0; j < 8; ++j) *(LAS u32x2*)(lds + L_BT + (n0 + j) * PIT + l0 * 2) = (u32x2){bt[j][0], bt[j][1]};
#pragma unroll
            for (int i = 0; i < 2; ++i) {
                const bool valid = (xl0 + i) >= lmin;
                const u32x4 vx = valid ? pX[i] : (u32x4){0u, 0u, 0u, 0u};
                const unsigned ws4[4] = {vx.x, vx.y, vx.z, vx.w};
#pragma unroll
                for (int j = 0; j < 8; ++j) { const unsigned q = (j & 1) ? (ws4[j >> 1] >> 16) : (ws4[j >> 1] & 0xffffu);
                    if (i & 1) xt[j] |= q << 16; else xt[j] = q; }
            }
#pragma unroll
            for (int j = 0; j < 8; ++j) *(LAS unsigned*)(lds + L_XT + (p0 + j) * PIT + xl0 * 2) = xt[j];
        }
        u32x2 zr[4];
        if (c > 0) {
#pragma unroll
            for (int k = 0; k < 4; ++k) zr[k] = *(const u32x2*)(proj + (size_t)(rb + lt * 32 + r) * NP + CZ + h * 64 + pt * 32 + 8 * k + 4 * hh);
        }
        float sd0 = 0.f, sd1 = 0.f;
        if (w == 1 && c < 16) scan_load(p, rb + 128, -3, h, sd0, sd1);
        if (c < 16) SSD_PREFETCH(rb + 128);
        __syncthreads();
        f32x16 cb0, cb1;
#pragma unroll
        for (int i = 0; i < 16; ++i) { cb0[i] = 0.f; cb1[i] = 0.f; }
        const int st0 = 2 * (w & 1);
        if (c > 0) {
            if (st0 <= lt) {
#pragma unroll
                for (int ks = 0; ks < 8; ++ks) {
                    const bf16x8 a = *(const LAS bf16x8*)(lds + L_CS + (lt * 32 + r) * PIT + (ks * 16 + hh * 8) * 2);
                    const bf16x8 b0 = *(const LAS bf16x8*)(lds + L_BS + (st0 * 32 + r) * PIT + (ks * 16 + hh * 8) * 2);
                    cb0 = __builtin_amdgcn_mfma_f32_32x32x16_bf16(a, b0, cb0, 0, 0, 0);
                    if (st0 + 1 <= lt) { const bf16x8 b1 = *(const LAS bf16x8*)(lds + L_BS + ((st0 + 1) * 32 + r) * PIT + (ks * 16 + hh * 8) * 2);
                        cb1 = __builtin_amdgcn_mfma_f32_32x32x16_bf16(a, b1, cb1, 0, 0, 0); }
                }
            }
        }
        __syncthreads();
        if (c > 0 && st0 <= lt) {
#pragma unroll
            for (int i = 0; i < 16; ++i) { const int l = lt * 32 + (i & 3) + 8 * (i >> 2) + 4 * hh;
                *(LAS bf16_t*)(lds + L_BS + l * PIT + (st0 * 32 + r) * 2) = (bf16_t)(cvt_pk_bf16(cb0[i], 0.f) & 0xffffu);
                if (st0 + 1 <= lt) *(LAS bf16_t*)(lds + L_BS + l * PIT + ((st0 + 1) * 32 + r) * 2) = (bf16_t)(cvt_pk_bf16(cb1[i], 0.f) & 0xffffu); }
        }
        __syncthreads();
        f32x16 aD, aO;
#pragma unroll
        for (int i = 0; i < 16; ++i) { aD[i] = 0.f; aO[i] = 0.f; }
        if (c > 0) {
            const int lrow = lt * 32 + r; const float acl = sm[F_ACS + buf * 128 + lrow];
            for (int ks = 0; ks < 2 * (lt + 1); ++ks) {
                const int s0 = ks * 16 + hh * 8;
                const u32x4 craw = *(const LAS u32x4*)(lds + L_BS + lrow * PIT + s0 * 2);
                float cbv[8]; unpack8(craw, cbv);
                const f32x4 as0 = *(const LAS f32x4*)(sm + F_ACS + buf * 128 + s0), as1 = *(const LAS f32x4*)(sm + F_ACS + buf * 128 + s0 + 4);
                const f32x4 dt0 = *(const LAS f32x4*)(sm + F_DT + buf * 128 + s0), dt1 = *(const LAS f32x4*)(sm + F_DT + buf * 128 + s0 + 4);
                float mv[8];
#pragma unroll
                for (int j = 0; j < 8; ++j) { const float as = j < 4 ? as0[j & 3] : as1[j & 3]; const float dd = j < 4 ? dt0[j & 3] : dt1[j & 3];
                    mv[j] = (s0 + j <= lrow) ? cbv[j] * __expf(acl - as) * dd : 0.f; }
                u32x4 ap; ap.x = cvt_pk_bf16(mv[0], mv[1]); ap.y = cvt_pk_bf16(mv[2], mv[3]); ap.z = cvt_pk_bf16(mv[4], mv[5]); ap.w = cvt_pk_bf16(mv[6], mv[7]);
                const bf16x8 a = __builtin_bit_cast(bf16x8, ap);
                const bf16x8 bx = *(const LAS bf16x8*)(lds + L_XT + (pt * 32 + r) * PIT + s0 * 2);
                aD = __builtin_amdgcn_mfma_f32_32x32x16_bf16(bx, a, aD, 0, 0, 0);
            }
#pragma unroll
            for (int ks = 0; ks < 8; ++ks) {
                const bf16x8 a = *(const LAS bf16x8*)(lds + L_CS + lrow * PIT + (ks * 16 + hh * 8) * 2);
                const bf16x8 bs = *(const LAS bf16x8*)(lds + L_SB + (pt * 32 + r) * PIT + (ks * 16 + hh * 8) * 2);
                aO = __builtin_amdgcn_mfma_f32_32x32x16_bf16(bs, a, aO, 0, 0, 0);
            }
        }
        {
            const float dec = __expf(sm[F_AEND + buf]);
#pragma unroll
            for (int i = 0; i < 16; ++i) accS[i] *= dec;
#pragma unroll
            for (int ks = 0; ks < 8; ++ks) {
                const bf16x8 a = *(const LAS bf16x8*)(lds + L_XT + (pt2 * 32 + r) * PIT + (ks * 16 + hh * 8) * 2);
                const bf16x8 bb = *(const LAS bf16x8*)(lds + L_BT + (nt * 32 + r) * PIT + (ks * 16 + hh * 8) * 2);
                accS = __builtin_amdgcn_mfma_f32_32x32x16_bf16(a, bb, accS, 0, 0, 0);
            }
        }
        if (w == 1 && c < 16) scan_finish(sm, buf ^ 1, sd0, sd1, a_neg);
        if (c > 0) {
            const int l = lt * 32 + r; const float eacs = __expf(sm[F_ACS + buf * 128 + l]);
            float q = 0.f;
#pragma unroll
            for (int k = 0; k < 4; ++k) {
                const int pl = pt * 32 + 8 * k + 4 * hh;
                const float z4[4] = {bf_lo(zr[k].x), bf_hi(zr[k].x), bf_lo(zr[k].y), bf_hi(zr[k].y)};
                float gv[4];
#pragma unroll
                for (int j = 0; j < 4; ++j) { const int i = 4 * k + j;
                    const float xv = bf1(*(const LAS bf16_t*)(lds + L_XT + (pl + j) * PIT + l * 2));
                    const float y = aD[i] + eacs * aO[i] + Dh * xv;
                    gv[j] = y * silu_f(z4[j]); q += gv[j] * gv[j]; }
                u32x2 pk; pk.x = cvt_pk_bf16(gv[0], gv[1]); pk.y = cvt_pk_bf16(gv[2], gv[3]);
                *(u32x2*)(ymix + (size_t)(base + l) * KO + h * 64 + pl) = pk;
            }
            q += __shfl_xor(q, 32);
            if (hh == 0) sm[F_SSL + pt * 128 + l] = q;
        }
        __syncthreads();
        if (c > 0 && tid < 128) unsafeAtomicAdd(ssq1 + base + tid, sm[F_SSL + tid] + sm[F_SSL + 128 + tid]);
#pragma unroll
        for (int i = 0; i < 16; ++i) { const int pp = pt2 * 32 + (i & 3) + 8 * (i >> 2) + 4 * hh;
            *(LAS bf16_t*)(lds + L_SB + pp * PIT + (nt * 32 + r) * 2) = (bf16_t)(cvt_pk_bf16(accS[i], 0.f) & 0xffffu); }
    }
#undef SSD_PREFETCH
    float* so = p.out + O_SSMP + ((size_t)(b * 32 + h) * 64) * 128;
#pragma unroll
    for (int i = 0; i < 16; ++i) { const int pp = pt2 * 32 + (i & 3) + 8 * (i >> 2) + 4 * hh; so[(size_t)pp * 128 + nt * 32 + r] = accS[i]; }
    __syncthreads();
}

__device__ __forceinline__ float block_sum(float v, LAS float* red) {
    v = wave_sum(v);
    __syncthreads();
    if ((threadIdx.x & 63) == 0) red[threadIdx.x >> 6] = v;
    __syncthreads();
    float s = 0.f;
#pragma unroll
    for (int i = 0; i < 8; ++i) s += red[i];
    return s;
}

__device__ void decode_item(const Params& p, LAS unsigned char* lds, int j) {
    const int tid = threadIdx.x, lane = tid & 63, w = tid >> 6;
    const bf16_t* proj = (const bf16_t*)(p.ws + WS_PROJ);
    bf16_t* ymix = (bf16_t*)(p.ws + WS_YMIX);
    const int R = YROW_S0 + j;
    const bf16_t* prow = proj + (size_t)(ROW_S0 + j) * NP;
    LAS float* xc = (LAS float*)lds;
    LAS float* yv = xc + 3072;
    LAS float* dts = yv + 2048;
    LAS float* dAs = dts + 32;
    LAS float* red = dAs + 32;
    {
        const float* cs = p.state_ssd_conv + (size_t)j * 3 * DXBC; float* co = p.out + O_CSS + (size_t)j * 3 * DXBC;
#pragma unroll
        for (int k = 0; k < 6; ++k) { const int col = tid + 512 * k;
            const float raw = bf1(prow[CX + col]); const float s0 = cs[col], s1 = cs[DXBC + col], s2 = cs[2 * DXBC + col];
            const float a = p.conv_ssd_b[col] + p.conv_ssd_w[col] * s0 + p.conv_ssd_w[DXBC + col] * s1 + p.conv_ssd_w[2 * DXBC + col] * s2 + p.conv_ssd_w[3 * DXBC + col] * raw;
            xc[col] = silu_f(a);
            co[col] = s1; co[DXBC + col] = s2; co[2 * DXBC + col] = raw; }
        if (tid < 32) { const float d = softplus_f(bf1(prow[CDT + tid]) + p.dt_bias[tid]); dts[tid] = d; dAs[tid] = __expf(d * (-__expf(p.a_log[tid]))); }
    }
    __syncthreads();
    {
        const int g = w >> 1, q = lane & 31, half = lane >> 5;
        const f32x4 Bq = *(const LAS f32x4*)(xc + 2048 + g * 128 + 4 * q), Cq = *(const LAS f32x4*)(xc + 2560 + g * 128 + 4 * q);
        const float* sin = p.state_ssm + (size_t)j * 32 * 64 * 128; float* sout = p.out + O_SSMS + (size_t)j * 32 * 64 * 128;
        for (int hq = 0; hq < 4; ++hq) {
            const int h = 4 * w + hq; const float dtv = dts[h], dA = dAs[h], Dh = p.d_skip[h];
            for (int it0 = 0; it0 < 32; it0 += 16) {
                f32x4 sv[16];
#pragma unroll
                for (int u = 0; u < 16; ++u) { const int pp = 2 * (it0 + u) + half; sv[u] = __builtin_nontemporal_load((const f32x4*)(sin + ((size_t)h * 64 + pp) * 128 + 4 * q)); }
#pragma unroll
                for (int u = 0; u < 16; ++u) { const int pp = 2 * (it0 + u) + half; const float xv = xc[h * 64 + pp]; const float xd = xv * dtv;
                    const f32x4 sn = sv[u] * dA + Bq * xd;
                    __builtin_nontemporal_store(sn, (f32x4*)(sout + ((size_t)h * 64 + pp) * 128 + 4 * q));
                    float yp = (sn[0] * Cq[0] + sn[1] * Cq[1]) + (sn[2] * Cq[2] + sn[3] * Cq[3]);
#pragma unroll
                    for (int o = 16; o >= 1; o >>= 1) yp += __shfl_xor(yp, o);
                    if (q == 0) yv[h * 64 + pp] = yp + Dh * xv; }
            }
        }
    }
    __syncthreads();
    {
        const int c0 = tid * 4; const u32x2 zz = *(const u32x2*)(prow + CZ + c0);
        const float z[4] = {bf_lo(zz.x), bf_hi(zz.x), bf_lo(zz.y), bf_hi(zz.y)};
        float gv[4]; float ss = 0.f;
#pragma unroll
        for (int k = 0; k < 4; ++k) { gv[k] = yv[c0 + k] * silu_f(z[k]); ss += gv[k] * gv[k]; }
        const float tot = block_sum(ss, red); const float rs = __builtin_amdgcn_rsqf(tot * (1.0f / 2048.f) + EPS);
        u32x2 pk; pk.x = cvt_pk_bf16(gv[0] * rs, gv[1] * rs); pk.y = cvt_pk_bf16(gv[2] * rs, gv[3] * rs);
        *(u32x2*)(ymix + (size_t)R * KO + c0) = pk;
    }
    {
        const int c0 = tid * 4;
        const u32x2 zz = *(const u32x2*)(prow + CZS + c0), bb = *(const u32x2*)(prow + CBS + c0), cc = *(const u32x2*)(prow + CCS + c0), hh4 = *(const u32x2*)(prow + CHS + c0);
        const float z[4] = {bf_lo(zz.x), bf_hi(zz.x), bf_lo(zz.y), bf_hi(zz.y)}, bv[4] = {bf_lo(bb.x), bf_hi(bb.x), bf_lo(bb.y), bf_hi(bb.y)};
        const float cv[4] = {bf_lo(cc.x), bf_hi(cc.x), bf_lo(cc.y), bf_hi(cc.y)}, hv[4] = {bf_lo(hh4.x), bf_hi(hh4.x), bf_lo(hh4.y), bf_hi(hh4.y)};
        const float* ss_in = p.state_short_conv + (size_t)j * 2 * DM; float* so = p.out + O_SCS + (size_t)j * 2 * DM;
        const f32x4 s0 = *(const f32x4*)(ss_in + c0), s1 = *(const f32x4*)(ss_in + DM + c0);
        const f32x4 w0 = *(const f32x4*)(p.conv_sc_w + c0), w1 = *(const f32x4*)(p.conv_sc_w + DM + c0), w2 = *(const f32x4*)(p.conv_sc_w + 2 * DM + c0);
        float y[4]; f32x4 vn; float ss = 0.f;
#pragma unroll
        for (int k = 0; k < 4; ++k) { const float v = cv[k] * hv[k]; vn[k] = v; y[k] = bv[k] * (w0[k] * s0[k] + w1[k] * s1[k] + w2[k] * v) * silu_f(z[k]); ss += y[k] * y[k]; }
        *(f32x4*)(so + c0) = s1; *(f32x4*)(so + DM + c0) = vn;
        const float tot = block_sum(ss, red); const float rs = __builtin_amdgcn_rsqf(tot * (1.0f / 2048.f) + EPS);
        u32x2 pk; pk.x = cvt_pk_bf16(y[0] * rs, y[1] * rs); pk.y = cvt_pk_bf16(y[2] * rs, y[3] * rs);
        *(u32x2*)(ymix + (size_t)R * KO + 2048 + c0) = pk;
    }
    __syncthreads();
}

__device__ void sc_item(const Params& p, int item) {
    const int tid = threadIdx.x, lane = tid & 63, w = tid >> 6;
    const bf16_t* proj = (const bf16_t*)(p.ws + WS_PROJ);
    bf16_t* ymix = (bf16_t*)(p.ws + WS_YMIX);
    float* ssq2 = (float*)(p.ws + WS_SSQ2);
    const int t0 = item * 64; const int b = t0 >> 11, tpos = t0 & 2047;
    const int pr0 = t0 + NMETA * (b + 1);
    const int c0 = w * 256 + lane * 4;
    const f32x4 w0 = *(const f32x4*)(p.conv_sc_w + c0), w1 = *(const f32x4*)(p.conv_sc_w + DM + c0), w2 = *(const f32x4*)(p.conv_sc_w + 2 * DM + c0);
    f32x4 vm2, vm1;
    {
        const int g2 = pr0 - 2, g1 = pr0 - 1;
        const u32x2 c2 = *(const u32x2*)(proj + (size_t)g2 * NP + CCS + c0), h2 = *(const u32x2*)(proj + (size_t)g2 * NP + CHS + c0);
        const u32x2 c1 = *(const u32x2*)(proj + (size_t)g1 * NP + CCS + c0), h1 = *(const u32x2*)(proj + (size_t)g1 * NP + CHS + c0);
        vm2 = (f32x4){bf_lo(c2.x) * bf_lo(h2.x), bf_hi(c2.x) * bf_hi(h2.x), bf_lo(c2.y) * bf_lo(h2.y), bf_hi(c2.y) * bf_hi(h2.y)};
        vm1 = (f32x4){bf_lo(c1.x) * bf_lo(h1.x), bf_hi(c1.x) * bf_hi(h1.x), bf_lo(c1.y) * bf_lo(h1.y), bf_hi(c1.y) * bf_hi(h1.y)};
    }
    for (int i0 = 0; i0 < 64; i0 += 8) {
        u32x2 zz[8], bb[8], cc[8], hh[8];
#pragma unroll
        for (int u = 0; u < 8; ++u) { const bf16_t* pr = proj + (size_t)(pr0 + i0 + u) * NP + c0;
            zz[u] = *(const u32x2*)(pr + CZS); bb[u] = *(const u32x2*)(pr + CBS); cc[u] = *(const u32x2*)(pr + CCS); hh[u] = *(const u32x2*)(pr + CHS); }
#pragma unroll
        for (int u = 0; u < 8; ++u) { const int t = t0 + i0 + u;
            const f32x4 v = (f32x4){bf_lo(cc[u].x) * bf_lo(hh[u].x), bf_hi(cc[u].x) * bf_hi(hh[u].x), bf_lo(cc[u].y) * bf_lo(hh[u].y), bf_hi(cc[u].y) * bf_hi(hh[u].y)};
            const f32x4 z = (f32x4){bf_lo(zz[u].x), bf_hi(zz[u].x), bf_lo(zz[u].y), bf_hi(zz[u].y)};
            const f32x4 bv = (f32x4){bf_lo(bb[u].x), bf_hi(bb[u].x), bf_lo(bb[u].y), bf_hi(bb[u].y)};
            const f32x4 cv = w0 * vm2 + w1 * vm1 + w2 * v;
            f32x4 y; float ss = 0.f;
#pragma unroll
            for (int k = 0; k < 4; ++k) { y[k] = bv[k] * cv[k] * silu_f(z[k]); ss += y[k] * y[k]; }
            ss = wave_sum(ss);
            if (lane == 0) atomicAdd(ssq2 + t, ss);
            u32x2 pk; pk.x = cvt_pk_bf16(y[0], y[1]); pk.y = cvt_pk_bf16(y[2], y[3]);
            *(u32x2*)(ymix + (size_t)t * KO + 2048 + c0) = pk;
            if ((t & 2047) == 2047) { float* so = p.out + O_SCP + (size_t)b * 2 * DM; *(f32x4*)(so + c0) = vm1; *(f32x4*)(so + DM + c0) = v; }
            vm2 = vm1; vm1 = v; }
    }
    if (tpos == 2048 - 64) {
        float* co = p.out + O_CSP + (size_t)b * 3 * DXBC;
        for (int i = tid; i < 3 * DXBC; i += 512) { const int rr = i / DXBC, col = i - rr * DXBC; co[i] = bf1(proj[(size_t)(b * BROWS + NMETA + 2045 + rr) * NP + CX + col]); }
    }
}

__device__ void sample_outproj(const Params& p, LAS unsigned char* lds) {
    const int tid = threadIdx.x, lane = tid & 63, w = tid >> 6;
    const bf16_t* ymix = (const bf16_t*)(p.ws + WS_YMIX); const bf16_t* WoutT = (const bf16_t*)(p.ws + WS_WOUT);
    const int strip = blockIdx.x >> 1, rhalf = blockIdx.x & 1; const int n0 = strip * 16;
    const int rg = w & 3, kh = w >> 2;
    const int fr = lane & 15, fq = lane >> 4;
    const bf16_t* ap = ymix + (size_t)(YROW_S0 + rhalf * 64 + rg * 16 + fr) * KO + kh * 2048 + fq * 8;
    const bf16_t* bp = WoutT + (size_t)(n0 + fr) * KO + kh * 2048 + fq * 8;
    f32x4 acc = (f32x4){0.f, 0.f, 0.f, 0.f};
    for (int ks = 0; ks < 64; ks += 16) {
        bf16x8 a[16], b[16];
#pragma unroll
        for (int u = 0; u < 16; ++u) { a[u] = *(const bf16x8*)(ap + (ks + u) * 32); b[u] = *(const bf16x8*)(bp + (ks + u) * 32); }
#pragma unroll
        for (int u = 0; u < 16; ++u) acc = __builtin_amdgcn_mfma_f32_16x16x32_bf16(a[u], b[u], acc, 0, 0, 0);
    }
    LAS f32x4* ex = (LAS f32x4*)lds;
    if (kh == 1) ex[rg * 64 + lane] = acc;
    __syncthreads();
    if (kh == 0) {
        acc += ex[rg * 64 + lane];
#pragma unroll
        for (int i = 0; i < 4; ++i) { const int srow = rhalf * 64 + rg * 16 + fq * 4 + i; p.out[O_YS + (size_t)srow * DM + n0 + fr] = acc[i]; }
    }
    __syncthreads();
}

__device__ void p4_final(const Params& p) {
    const int tid = threadIdx.x, lane = tid & 63, wid = tid >> 6;
    const int gw = blockIdx.x * 8 + wid, nw = gridDim.x * 8;
    f32x4 fw[8];
#pragma unroll
    for (int i = 0; i < 8; ++i) fw[i] = *(const f32x4*)(p.final_norm_w + i * 256 + lane * 4);
    for (int r = gw; r < 8192 + 128; r += nw) {
        float* o = r < 8192 ? p.out + O_YP + (size_t)r * DM : p.out + O_YS + (size_t)(r - 8192) * DM;
        const float* x = r < 8192 ? p.x_prompt + (size_t)r * DM : p.x_sample + (size_t)(r - 8192) * DM;
        f32x4 v[8]; float ss = 0.f;
#pragma unroll
        for (int i = 0; i < 8; ++i) { const f32x4 a = *(const f32x4*)(o + i * 256 + lane * 4), b = __builtin_nontemporal_load((const f32x4*)(x + i * 256 + lane * 4)); v[i] = a + b;
            ss += (v[i][0] * v[i][0] + v[i][1] * v[i][1]) + (v[i][2] * v[i][2] + v[i][3] * v[i][3]); }
        ss = wave_sum(ss);
        const float rs = __builtin_amdgcn_rsqf(ss * (1.0f / 2048.f) + EPS);
#pragma unroll
        for (int i = 0; i < 8; ++i) __builtin_nontemporal_store(v[i] * rs * fw[i], (f32x4*)(o + i * 256 + lane * 4));
    }
}

#define XB_TMO      128
#define XB_XCNT(j)  (256  + 64 * (j))
#define XB_XSUB(j)  (1280 + 64 * (j))
#define XB_XGEN(j)  (2304 + 64 * (j))
#define XB_TOP      3328
#define XB_TOPGEN   3392
#define XCD_BAR_WORDS 3456
#define XB_SPIN_CAP (1u << 18)
__device__ __forceinline__ unsigned xb_ld(unsigned* p)              { return __hip_atomic_load(p, __ATOMIC_RELAXED, __HIP_MEMORY_SCOPE_AGENT); }
__device__ __forceinline__ unsigned xb_add(unsigned* p, unsigned v) { return __hip_atomic_fetch_add(p, v, __ATOMIC_RELAXED, __HIP_MEMORY_SCOPE_AGENT); }
__device__ __forceinline__ unsigned xb_xcc_id() { return (unsigned)__builtin_amdgcn_s_getreg((3 << 11) | 20) & 0xFu; }
#define XB_SPIN(cond, bar) do { unsigned _sp = 0; while (cond) { __builtin_amdgcn_s_sleep(1); \
    if ((++_sp & 255u) == 0u) { if (xb_ld(&(bar)[XB_TMO])) break; if (_sp > XB_SPIN_CAP) { atomicAdd(&(bar)[XB_TMO], 1u); break; } } } } while (0)
struct XcdBarrier { unsigned* bar; unsigned x; volatile LAS unsigned* st; };
__device__ __forceinline__ XcdBarrier xcd_barrier_post(unsigned* bar, volatile LAS unsigned* st) {
    XcdBarrier b; b.bar = bar; b.x = xb_xcc_id(); b.st = st;
    if (threadIdx.x == 0) (void)xb_add(&bar[XB_XCNT(b.x)], 1u);
    return b;
}
__device__ __forceinline__ void xcd_barrier_complete(unsigned* bar, unsigned x, unsigned& nloc, unsigned& nx) {
    const unsigned G = gridDim.x * gridDim.y * gridDim.z;
    unsigned sum, cnt, mine, sp = 0u;
    for (;;) {
        sum = 0u; cnt = 0u; mine = 0u;
#pragma unroll
        for (unsigned j = 0; j < 16; ++j) { const unsigned c = xb_ld(&bar[XB_XCNT(j)]); sum += c; cnt += (c > 0u) ? 1u : 0u; mine = (j == x) ? c : mine; }
        if (sum == G) break;
        __builtin_amdgcn_s_sleep(1);
        if ((++sp & 255u) == 0u) { if (xb_ld(&bar[XB_TMO])) break; if (sp > XB_SPIN_CAP) { atomicAdd(&bar[XB_TMO], 1u); break; } }
    }
    nloc = mine > 0u ? mine : 1u; nx = cnt > 0u ? cnt : 1u;
}
__device__ __forceinline__ void xcd_barrier(const XcdBarrier& b) {
    asm volatile("s_waitcnt vmcnt(0)" ::: "memory");
    __syncthreads();
    if (threadIdx.x == 0) {
        unsigned* bar = b.bar;
        __builtin_amdgcn_s_waitcnt(0);
        unsigned nloc = b.st[0], nx = b.st[1];
        if (nloc == 0u) { xcd_barrier_complete(bar, b.x, nloc, nx); b.st[0] = nloc; b.st[1] = nx; }
        const unsigned old = xb_add(&bar[XB_XSUB(b.x)], 1u);
        const unsigned gen = old / nloc;
        if (old + 1u == (gen + 1u) * nloc) {
            __builtin_amdgcn_fence(__ATOMIC_RELEASE, "agent");
            asm volatile("s_waitcnt vmcnt(0)" ::: "memory");
            const unsigned og = xb_add(&bar[XB_TOP], 1u);
            const unsigned tg = og / nx;
            if (og + 1u == (tg + 1u) * nx) xb_add(&bar[XB_TOPGEN], 1u);
            else XB_SPIN(xb_ld(&bar[XB_TOPGEN]) == tg, bar);
            __builtin_amdgcn_fence(__ATOMIC_ACQUIRE, "agent");
            xb_add(&bar[XB_XGEN(b.x)], 1u);
            asm volatile("s_waitcnt vmcnt(0)" ::: "memory");
        } else {
            XB_SPIN(xb_ld(&bar[XB_XGEN(b.x)]) == gen, bar);
            __builtin_amdgcn_fence(__ATOMIC_ACQUIRE, "agent");
            asm volatile("s_waitcnt vmcnt(0)" ::: "memory");
        }
    }
    __syncthreads();
}

__global__ void __launch_bounds__(512, 2) hymba_fwd(Params p) {
    extern __shared__ __attribute__((aligned(16))) unsigned char lds_raw[];
    LAS unsigned char* lds = (LAS unsigned char*)lds_raw;
    cg::grid_group grid = cg::this_grid();
    const int lo = p.ph_lo, hi = p.ph_hi;
#ifdef ONLY
#define IN(k) ((k) == ONLY && lo <= (k) && (k) < hi)
#else
#define IN(k) (lo <= (k) && (k) < hi)
#endif
#define SEAM(k) do { if (IN(k) && IN((k) + 1)) xcd_barrier(xb); } while (0)
    unsigned* barw = (unsigned*)(p.ws + WS_BAR);
    XcdBarrier xb; xb.bar = barw; xb.x = 0; xb.st = (volatile LAS unsigned*)(lds + LDS_BYTES - 16);
    if (IN(0)) {
        if (blockIdx.x == 0) for (int i = threadIdx.x; i < 3456; i += 512) barw[i] = 0u;
        p0_prep(p, lds);
    }
    if (IN(0) && IN(1)) {
        grid.sync();
        if (threadIdx.x < 4) ((volatile LAS unsigned*)(lds + LDS_BYTES - 16))[threadIdx.x] = 0u;
        __syncthreads();
        xb = xcd_barrier_post(barw, (volatile LAS unsigned*)(lds + LDS_BYTES - 16));
    }
    if (IN(1)) {
        pg8::Gemm g{(const bf16_t*)(p.ws + WS_HN), (const bf16_t*)(p.ws + WS_WIN), MP, NP, DM};
        pg8::StaticOrder S; S.init(MP, NP, (int)gridDim.x, (int)blockIdx.x);
        pg8::EpiProj E{(bf16_t*)(p.ws + WS_PROJ), NP};
        pg8::gemm_phase<pg8::EpiProj>(lds, g, S, E);
    }
    SEAM(1);
    if (IN(2)) conv_pre(p);
    SEAM(2);
    if (IN(3)) {
        const int it = blockIdx.x;
        if (it < 128) { if (!(p.flags & 8)) ssd_item(p, lds, it); }
        else { if (!(p.flags & 4)) decode_item(p, lds, it - 128); if (!(p.flags & 16)) sc_item(p, it - 128); }
    }
    SEAM(3);
    if (IN(4)) {
        if (!(p.flags & 1)) sample_outproj(p, lds);
        pg8::Gemm g{(const bf16_t*)(p.ws + WS_YMIX), (const bf16_t*)(p.ws + WS_WOUT), 8192, DM, KO};
        pg8::StaticOrder S; S.init(8192, DM, (int)gridDim.x, (int)blockIdx.x);
        LAS float* tab = (LAS float*)(lds + pg8::STAGE_BYTES);
        { pg8::Unit u0; S.next(0, u0);
          if (threadIdx.x < 256) { const int r = u0.pm * 256 + threadIdx.x; const float s1 = ((const float*)(p.ws + WS_SSQ1))[r], s2 = ((const float*)(p.ws + WS_SSQ2))[r];
              const float q1 = s1 * (1.0f / 2048.f) + EPS, q2 = s2 * (1.0f / 2048.f) + EPS;
              tab[threadIdx.x] = __builtin_sqrtf(q2 / q1); tab[256 + threadIdx.x] = __builtin_amdgcn_rsqf(q2); }
          __syncthreads(); }
        pg8::EpiOut E{p.out + O_YP, tab};
        if (!(p.flags & 2)) pg8::gemm_phase<pg8::EpiOut>(lds, g, S, E);
    }
    SEAM(4);
    if (IN(5)) p4_final(p);
#undef IN
#undef SEAM
}

extern "C" void kernel_launch(void* const* d_in, const int* in_sizes, int n_in, void* d_out, int out_size, void* d_ws, size_t ws_size, hipStream_t stream) {
    static int grid = 0;
    if (grid == 0) {
        int dev = 0, cus = 0, per_cu = 0;
        hipGetDevice(&dev); hipDeviceGetAttribute(&cus, hipDeviceAttributeMultiprocessorCount, dev);
        hipFuncSetAttribute((const void*)hymba_fwd, hipFuncAttributeMaxDynamicSharedMemorySize, LDS_BYTES);
        hipOccupancyMaxActiveBlocksPerMultiprocessor(&per_cu, (const void*)hymba_fwd, 512, LDS_BYTES);
        if (per_cu < 1) per_cu = 1;
        grid = cus * 1;
        if (grid > 256) grid = 256;
        if (ws_size < WS_END) { fprintf(stderr, "workspace too small: %zu < %zu\n", ws_size, (size_t)WS_END); }
    }
    Params p{};
    p.x_prompt = (const float*)d_in[0]; p.x_sample = (const float*)d_in[1]; p.state_ssm = (const float*)d_in[2]; p.state_ssd_conv = (const float*)d_in[3];
    p.state_short_conv = (const float*)d_in[4]; p.meta = (const float*)d_in[5]; p.norm_w = (const float*)d_in[6]; p.w_in = (const float*)d_in[7];
    p.conv_ssd_w = (const float*)d_in[8]; p.conv_ssd_b = (const float*)d_in[9]; p.dt_bias = (const float*)d_in[10]; p.a_log = (const float*)d_in[11];
    p.d_skip = (const float*)d_in[12]; p.ssd_norm_w = (const float*)d_in[13]; p.conv_sc_w = (const float*)d_in[14]; p.sc_norm_w = (const float*)d_in[15];
    p.w_out = (const float*)d_in[16]; p.final_norm_w = (const float*)d_in[17];
    p.out = (float*)d_out; p.ws = (unsigned char*)d_ws;
#if N_LAUNCH == 1
    p.ph_lo = 0; p.ph_hi = 6;
    void* args[] = {&p};
    hipError_t e = hipLaunchCooperativeKernel((const void*)hymba_fwd, dim3(grid), dim3(512), args, LDS_BYTES, stream);
    if (e != hipSuccess) fprintf(stderr, "cooperative launch failed: %s (grid %d)\n", hipGetErrorString(e), grid);
#else
    const int sched[][3] = {SCHED};
    for (unsigned li = 0; li < sizeof(sched) / sizeof(sched[0]); ++li) {
        p.ph_lo = sched[li][0]; p.ph_hi = sched[li][1]; p.flags = sched[li][2];
        void* args[] = {&p};
        hipError_t e = hipLaunchCooperativeKernel((const void*)hymba_fwd, dim3(grid), dim3(512), args, LDS_BYTES, stream);
        if (e != hipSuccess) fprintf(stderr, "cooperative launch failed: %s (grid %d)\n", hipGetErrorString(e), grid);
    }
#endif
}
```

```cpp
#include <hip/hip_runtime.h>
#include <hip/hip_cooperative_groups.h>
#include <cstdio>
namespace cg = cooperative_groups;

#define LAS __attribute__((address_space(3)))
typedef unsigned short bf16_t;
typedef short bf16x8 __attribute__((ext_vector_type(8)));
typedef float f32x4 __attribute__((ext_vector_type(4)));
typedef float f32x16 __attribute__((ext_vector_type(16)));
typedef unsigned u32x4 __attribute__((ext_vector_type(4)));
typedef unsigned u32x2 __attribute__((ext_vector_type(2)));

#ifndef N_LAUNCH
#define N_LAUNCH 1
#endif
#define REP0 1
#define REP1 1
#define REP3 1
#define SCHED {0,6,0}

constexpr int DM = 2048;
constexpr int SEQ = 2048, NB = 4, NS = 128, NMETA = 16;
constexpr int NPROJ = 13344;
constexpr int NP = 13568;
constexpr int MP = 8448;
constexpr int BROWS = 2064;
constexpr int ROW_S0 = 8256;
constexpr int ROW_END = 8384;
constexpr int YROW_S0 = 8192;
constexpr int DXBC = 3072;
constexpr int CZ = 0, CX = 2048, CBm = 4096, CCm = 4608, CZS = 5120, CBS = 7168, CCS = 9216, CHS = 11264, CDT = 13312;
constexpr int KO = 4096;
constexpr float EPS = 1e-5f;

constexpr size_t O_YP = 0;
constexpr size_t O_YS = O_YP + (size_t)NB * SEQ * DM;
constexpr size_t O_SSMP = O_YS + (size_t)NS * DM;
constexpr size_t O_CSP = O_SSMP + (size_t)NB * 32 * 64 * 128;
constexpr size_t O_SCP = O_CSP + (size_t)NB * 3 * DXBC;
constexpr size_t O_SSMS = O_SCP + (size_t)NB * 2 * DM;
constexpr size_t O_CSS = O_SSMS + (size_t)NS * 32 * 64 * 128;
constexpr size_t O_SCS = O_CSS + (size_t)NS * 3 * DXBC;

constexpr size_t WS_WIN = 0;
constexpr size_t WS_WOUT = WS_WIN + (size_t)NP * DM * 2;
constexpr size_t WS_HN = WS_WOUT + (size_t)DM * KO * 2;
constexpr size_t WS_PROJ = WS_HN + (size_t)MP * DM * 2;
constexpr size_t WS_YMIX = WS_PROJ + (size_t)MP * NP * 2;
constexpr size_t WS_SSQ1 = WS_YMIX + (size_t)MP * KO * 2;
constexpr size_t WS_SSQ2 = WS_SSQ1 + (size_t)MP * 4;
constexpr size_t WS_SSQ3 = WS_SSQ2 + (size_t)MP * 4;
constexpr size_t WS_SSQ4 = WS_SSQ3 + (size_t)8192 * 32 * 4;
constexpr size_t WS_XC = WS_SSQ4 + (size_t)128 * 128 * 4;
constexpr size_t WS_DTV = WS_XC + (size_t)MP * DXBC * 2;
constexpr size_t WS_BAR = WS_DTV + (size_t)MP * 32 * 4;
constexpr size_t WS_END = WS_BAR + 16384;

constexpr int LDS_BYTES = 147456;

struct Params {
    const float* x_prompt; const float* x_sample; const float* state_ssm; const float* state_ssd_conv; const float* state_short_conv;
    const float* meta; const float* norm_w; const float* w_in; const float* conv_ssd_w; const float* conv_ssd_b; const float* dt_bias;
    const float* a_log; const float* d_skip; const float* ssd_norm_w; const float* conv_sc_w; const float* sc_norm_w; const float* w_out;
    const float* final_norm_w;
    float* out; unsigned char* ws;
    int ph_lo, ph_hi, flags, pad;
};

__device__ __forceinline__ unsigned cvt_pk_bf16(float lo, float hi) { unsigned r; asm("v_cvt_pk_bf16_f32 %0, %1, %2" : "=v"(r) : "v"(lo), "v"(hi)); return r; }
__device__ __forceinline__ float bf_lo(unsigned u) { return __uint_as_float(u << 16); }
__device__ __forceinline__ float bf_hi(unsigned u) { return __uint_as_float(u & 0xffff0000u); }
__device__ __forceinline__ float bf1(bf16_t u) { return __uint_as_float(((unsigned)u) << 16); }
__device__ __forceinline__ float silu_f(float x) { return x * __builtin_amdgcn_rcpf(1.0f + __expf(-x)); }
__device__ __forceinline__ float softplus_f(float x) { return x > 20.f ? x : log1pf(__expf(x)); }
template <int CTRL> __device__ __forceinline__ float dpp_f(float v) { return __int_as_float(__builtin_amdgcn_update_dpp(0, __float_as_int(v), CTRL, 0xF, 0xF, false)); }
__device__ __forceinline__ float sum8_dpp(float v) { v += dpp_f<0xB1>(v); v += dpp_f<0x4E>(v); v += dpp_f<0x141>(v); return v; }
__device__ __forceinline__ float wave_sum(float v) {
    v = sum8_dpp(v);
    v += __shfl_xor(v, 8); v += __shfl_xor(v, 16); v += __shfl_xor(v, 32);
    return v;
}
__device__ __forceinline__ void unpack8(const u32x4 u, float (&f)[8]) {
    f[0] = bf_lo(u.x); f[1] = bf_hi(u.x); f[2] = bf_lo(u.y); f[3] = bf_hi(u.y); f[4] = bf_lo(u.z); f[5] = bf_hi(u.z); f[6] = bf_lo(u.w); f[7] = bf_hi(u.w);
}

namespace pg8 {
constexpr int BM = 256, BK = 64, HALF = 128, HTB = HALF * BK * 2, STAGE_BYTES = 8 * HTB, NXCD = 8, WGM = 8;
__device__ __forceinline__ int lds_byte(int r, int c) { const int st = (r >> 4) * 2 + (c >> 5), rr = r & 15, cc = c & 31, ob = rr * 64 + cc * 2; return st * 1024 + (ob ^ (((ob >> 9) & 1) << 5)); }
__device__ __forceinline__ void stage_rc(int b, int& R, int& C) { const int st = b / 1024, sb = b % 1024, swz = sb ^ (((sb >> 9) & 1) << 5); R = (st >> 1) * 16 + swz / 64; C = (st & 1) * 32 + (swz % 64) / 2; }
__device__ __forceinline__ int perm32(int rho) { const int n = rho >> 4, i = rho & 15; return 8 * (i >> 2) + 4 * n + (i & 3); }
struct Unit { int pm, pn; };
struct Gemm { const bf16_t* A; const bf16_t* Bt; int M, N, K; };
struct StaticOrder {
    int nM, nN, nwg, G, c;
    __device__ void init(int M, int N, int G_, int c_) { nM = M / BM; nN = N / BM; nwg = nM * nN; G = G_; c = c_; }
    __device__ bool next(int i, Unit& u) const {
        const long L = (long)i * G + c; if (L >= nwg) return false;
        int wgid = (int)L; { const int q = nwg / NXCD, r = nwg % NXCD, xcd = wgid % NXCD, off = wgid / NXCD; wgid = (xcd < r ? xcd * (q + 1) : r * (q + 1) + (xcd - r) * q) + off; }
        const int nig = WGM * nN, gid = wgid / nig, fm = gid * WGM, gsz = (nM - fm) < WGM ? (nM - fm) : WGM;
        u.pm = fm + ((wgid % nig) % gsz); u.pn = (wgid % nig) / gsz; return true;
    }
};

struct EpiProj {
    static constexpr bool PERM = true, MID = false;
    bf16_t* O; int ldc;
    __device__ __forceinline__ void mid(f32x4 (&acc)[2][2][4][2], const Unit& u, int wr, int wc, int fr, int fq) const {}
    __device__ __forceinline__ void operator()(const f32x4 (&acc)[2][2][4][2], const Unit& u, int wr, int wc, int fr, int fq) const {
        const int row0 = u.pm * BM + wr * 64 + fr; const int col0 = u.pn * BM + wc * 32 + 8 * fq;
#pragma unroll
        for (int ai = 0; ai < 2; ++ai)
#pragma unroll
            for (int m = 0; m < 4; ++m) { bf16_t* rowp = O + (size_t)(row0 + ai * HALF + m * 16) * ldc + col0;
#pragma unroll
                for (int bj = 0; bj < 2; ++bj) { const f32x4 v0 = acc[ai][bj][m][0], v1 = acc[ai][bj][m][1];
                    u32x4 w; w.x = cvt_pk_bf16(v0[0], v0[1]); w.y = cvt_pk_bf16(v0[2], v0[3]); w.z = cvt_pk_bf16(v1[0], v1[1]); w.w = cvt_pk_bf16(v1[2], v1[3]);
                    *(u32x4*)(rowp + bj * HALF) = w; } }
    }
};
struct EpiOut {
    static constexpr bool PERM = false, MID = true;
    float* C; LAS const float* tab;
    __device__ __forceinline__ void mid(f32x4 (&acc)[2][2][4][2], const Unit& u, int wr, int wc, int fr, int fq) const {
#pragma unroll
        for (int ai = 0; ai < 2; ++ai)
#pragma unroll
            for (int m = 0; m < 4; ++m) { const float f = tab[wr * 64 + fr + ai * HALF + m * 16];
#pragma unroll
                for (int bj = 0; bj < 2; ++bj)
#pragma unroll
                    for (int n = 0; n < 2; ++n) acc[ai][bj][m][n] *= f; }
    }
    __device__ __forceinline__ void operator()(const f32x4 (&acc)[2][2][4][2], const Unit& u, int wr, int wc, int fr, int fq) const {
        const int row0 = u.pm * BM + wr * 64 + fr, col0 = u.pn * BM + wc * 32 + 4 * fq;
#pragma unroll
        for (int ai = 0; ai < 2; ++ai)
#pragma unroll
            for (int m = 0; m < 4; ++m) { const int r = row0 + ai * HALF + m * 16;
                const float rs = tab[256 + wr * 64 + fr + ai * HALF + m * 16];
                float* rowp = C + (size_t)r * DM + col0;
#pragma unroll
                for (int bj = 0; bj < 2; ++bj)
#pragma unroll
                    for (int n = 0; n < 2; ++n) *(f32x4*)(rowp + bj * HALF + n * 16) = acc[ai][bj][m][n] * rs; }
    }
};

template <class Epi>
__device__ __forceinline__ void gemm_phase(LAS unsigned char* lds, const Gemm g, const StaticOrder& S, const Epi& E) {
    const int tid = threadIdx.x, wid = __builtin_amdgcn_readfirstlane(tid >> 6), lane = tid & 63, wr = wid >> 2, wc = wid & 3, fr = lane & 15, fq = lane >> 4;
    const int K = g.K, nt = K / BK;
    unsigned voffA[2], voffB[2];
#pragma unroll
    for (int i = 0; i < 2; ++i) { int R, C; stage_rc(tid * 16 + i * 8192, R, C); const int Rb = Epi::PERM ? ((R & ~31) + perm32(R & 31)) : R;
        voffA[i] = (unsigned)(R * K + C) * 2u; voffB[i] = (unsigned)(Rb * K + C) * 2u; }
    const size_t kstep = (size_t)(BK * 2);
    const size_t hstep = (size_t)HALF * K * 2;
    const size_t tstep = 2 * hstep;
    const unsigned ldsw = (unsigned)wid * 1024u;
    const int aoff = lds_byte(wr * 64 + fr, fq * 8), boff = lds_byte(wc * 32 + fr, fq * 8);
#define PG8_SA(b, h) (((b) * 2 + (h)) * HTB)
#define PG8_SB(b, h) ((4 + (b) * 2 + (h)) * HTB)
#define PG8_STAGE(bufoff, gbase, voff) do { _Pragma("unroll") for (int _i = 0; _i < 2; ++_i) \
        __builtin_amdgcn_global_load_lds((const unsigned*)((const char*)(gbase) + (voff)[_i]), (LAS unsigned*)(lds + (bufoff) + ldsw + _i * 8192), 16, 0, 0); } while (0)
#define PG8_LDA(dst, b, h) do { _Pragma("unroll") for (int m = 0; m < 4; ++m) _Pragma("unroll") for (int k = 0; k < 2; ++k) dst[m][k] = *(const LAS bf16x8*)(lds + PG8_SA(b, h) + aoff + m * 2048 + k * 1024); } while (0)
#define PG8_LDB(dst, b, h) do { _Pragma("unroll") for (int n = 0; n < 2; ++n) _Pragma("unroll") for (int k = 0; k < 2; ++k) dst[n][k] = *(const LAS bf16x8*)(lds + PG8_SB(b, h) + boff + n * 2048 + k * 1024); } while (0)
#define PG8_MMA(ai, bj, At, Bt) do { __builtin_amdgcn_s_setprio(1); _Pragma("unroll") for (int m = 0; m < 4; ++m) _Pragma("unroll") for (int n = 0; n < 2; ++n) _Pragma("unroll") for (int k = 0; k < 2; ++k) \
        acc[ai][bj][m][n] = __builtin_amdgcn_mfma_f32_16x16x32_bf16(Bt[n][k], At[m][k], acc[ai][bj][m][n], 0, 0, 0); __builtin_amdgcn_s_setprio(0); } while (0)
#define PG8_WAIT_V(n) asm volatile("s_waitcnt vmcnt(" #n ")" ::: "memory")
#define PG8_WAIT_L(n) asm volatile("s_waitcnt lgkmcnt(" #n ")" ::: "memory")
#define PG8_BAR __builtin_amdgcn_s_barrier()
#define PG8_SCHED __builtin_amdgcn_sched_barrier(0)
    Unit cur, nxt; int ui = 0;
    if (!S.next(0, cur)) return;
    f32x4 acc[2][2][4][2];
#pragma unroll
    for (int a = 0; a < 2; ++a)
#pragma unroll
        for (int b = 0; b < 2; ++b)
#pragma unroll
            for (int m = 0; m < 4; ++m)
#pragma unroll
                for (int n = 0; n < 2; ++n) acc[a][b][m][n] = (f32x4){0.f, 0.f, 0.f, 0.f};
    bf16x8 At[4][2], B0[2][2], B1[2][2];
    const char* cA = (const char*)g.A + (size_t)cur.pm * tstep; const char* cB = (const char*)g.Bt + (size_t)cur.pn * tstep;
    PG8_STAGE(PG8_SB(0, 0), cB, voffB); PG8_STAGE(PG8_SA(0, 0), cA, voffA); PG8_STAGE(PG8_SB(0, 1), cB + hstep, voffB); PG8_STAGE(PG8_SA(0, 1), cA + hstep, voffA);
    if (wr == 1) PG8_BAR;
    PG8_WAIT_V(4); PG8_BAR;
    PG8_STAGE(PG8_SB(1, 0), cB + kstep, voffB); PG8_STAGE(PG8_SA(1, 0), cA + kstep, voffA); PG8_STAGE(PG8_SB(1, 1), cB + hstep + kstep, voffB);
    PG8_WAIT_V(6); PG8_BAR;
    for (;;) {
        const bool has_next = S.next(ui + 1, nxt);
        const char* nA = has_next ? (const char*)g.A + (size_t)nxt.pm * tstep : cA; const char* nB = has_next ? (const char*)g.Bt + (size_t)nxt.pn * tstep : cB;
        for (int t = 0; t < nt; t += 2) {
            const bool last = (t == nt - 2);
            const char* a1 = cA + (size_t)(t + 1) * kstep;
            const char* a2 = last ? nA : cA + (size_t)(t + 2) * kstep; const char* b2 = last ? nB : cB + (size_t)(t + 2) * kstep;
            const char* a3 = a2 + kstep; const char* b3 = b2 + kstep;
            if constexpr (Epi::MID) { if (t == (nt >> 1)) E.mid(acc, cur, wr, wc, fr, fq); }
            PG8_LDB(B0, 0, 0); PG8_SCHED; PG8_LDA(At, 0, 0); PG8_STAGE(PG8_SA(1, 1), a1 + hstep, voffA);
            PG8_WAIT_L(8); PG8_BAR; PG8_WAIT_L(0); PG8_MMA(0, 0, At, B0); PG8_BAR; PG8_SCHED;
            PG8_LDB(B1, 0, 1); PG8_STAGE(PG8_SB(0, 0), b2, voffB);
            PG8_BAR; PG8_WAIT_L(0); PG8_MMA(0, 1, At, B1); PG8_BAR;
            PG8_LDA(At, 0, 1); PG8_STAGE(PG8_SA(0, 0), a2, voffA);
            PG8_BAR; PG8_WAIT_L(0); PG8_MMA(1, 0, At, B0); PG8_BAR; PG8_SCHED;
            PG8_STAGE(PG8_SB(0, 1), b2 + hstep, voffB);
            PG8_WAIT_V(6); PG8_BAR; PG8_MMA(1, 1, At, B1); PG8_BAR;
            PG8_LDB(B0, 1, 0); PG8_SCHED; PG8_LDA(At, 1, 0); PG8_STAGE(PG8_SA(0, 1), a2 + hstep, voffA);
            PG8_WAIT_L(8); PG8_BAR; PG8_WAIT_L(0); PG8_MMA(0, 0, At, B0); PG8_BAR; PG8_SCHED;
            PG8_LDB(B1, 1, 1); PG8_STAGE(PG8_SB(1, 0), b3, voffB);
            PG8_BAR; PG8_WAIT_L(0); PG8_MMA(0, 1, At, B1); PG8_BAR;
            PG8_LDA(At, 1, 1); PG8_STAGE(PG8_SA(1, 0), a3, voffA);
            PG8_BAR; PG8_WAIT_L(0); PG8_MMA(1, 0, At, B0); PG8_BAR; PG8_SCHED;
            PG8_STAGE(PG8_SB(1, 1), b3 + hstep, voffB);
            PG8_WAIT_V(6); PG8_BAR; PG8_MMA(1, 1, At, B1); PG8_BAR;
        }
        E(acc, cur, wr, wc, fr, fq);
        if (!has_next) break;
#pragma unroll
        for (int a = 0; a < 2; ++a)
#pragma unroll
            for (int b = 0; b < 2; ++b)
#pragma unroll
                for (int m = 0; m < 4; ++m)
#pragma unroll
                    for (int n = 0; n < 2; ++n) acc[a][b][m][n] = (f32x4){0.f, 0.f, 0.f, 0.f};
        cur = nxt; cA = nA; cB = nB; ++ui;
    }
    PG8_WAIT_V(0);
    if (wr == 0) PG8_BAR;
    PG8_BAR;
#undef PG8_SA
#undef PG8_SB
#undef PG8_STAGE
#undef PG8_LDA
#undef PG8_LDB
#undef PG8_MMA
#undef PG8_WAIT_V
#undef PG8_WAIT_L
#undef PG8_BAR
#undef PG8_SCHED
}
}

struct TrTile { const float* src; int spitch, scol0, nvalid, k0; bf16_t* dst; int dpitch, n0; const float* sc0; const float* sc1; };
__device__ __forceinline__ TrTile tr_desc(const Params& p, int t) {
    constexpr int T_IN = 212 * 16;
    TrTile d;
    if (t < T_IN) {
        const int nt_ = t >> 4, kt = t & 15; const int n0 = nt_ * 64;
        int scol, nvalid;
        if (n0 < 5120) { scol = n0; nvalid = 64; }
        else if (n0 < 13312) { scol = n0 + 32; nvalid = 64; }
        else if (n0 == 13312) { scol = 5120; nvalid = 32; }
        else { scol = 0; nvalid = 0; }
        d.src = p.w_in; d.spitch = NPROJ; d.scol0 = scol; d.nvalid = nvalid; d.k0 = kt * 128; d.dst = (bf16_t*)(p.ws + WS_WIN); d.dpitch = DM; d.n0 = n0; d.sc0 = nullptr; d.sc1 = nullptr;
    } else {
        const int tt = t - T_IN; const int nt_ = tt >> 5, kt = tt & 31;
        d.src = p.w_out; d.spitch = DM; d.scol0 = nt_ * 64; d.nvalid = 64; d.k0 = kt * 128; d.dst = (bf16_t*)(p.ws + WS_WOUT); d.dpitch = KO; d.n0 = nt_ * 64; d.sc0 = p.ssd_norm_w; d.sc1 = p.sc_norm_w;
    }
    return d;
}
__device__ __forceinline__ void tr_load(const TrTile& d, f32x4 (&r)[2][2], float (&sc)[2][2]) {
    const int tid = threadIdx.x, nq = tid & 15, kp = tid >> 4;
#pragma unroll
    for (int pass = 0; pass < 2; ++pass) {
        const int kg = d.k0 + pass * 64 + kp * 2;
        r[pass][0] = (f32x4){0.f, 0.f, 0.f, 0.f}; r[pass][1] = r[pass][0];
        if (nq * 4 < d.nvalid) {
            r[pass][0] = __builtin_nontemporal_load((const f32x4*)(d.src + (size_t)kg * d.spitch + d.scol0 + nq * 4));
            r[pass][1] = __builtin_nontemporal_load((const f32x4*)(d.src + (size_t)(kg + 1) * d.spitch + d.scol0 + nq * 4));
        }
        sc[pass][0] = 1.f; sc[pass][1] = 1.f;
        if (d.sc0) { sc[pass][0] = (kg < 2048) ? d.sc0[kg] : d.sc1[kg - 2048]; sc[pass][1] = (kg + 1 < 2048) ? d.sc0[kg + 1] : d.sc1[kg + 1 - 2048]; }
    }
}
__device__ __forceinline__ void tr_store(LAS unsigned char* lds, const TrTile& d, const f32x4 (&r)[2][2], const float (&sc)[2][2]) {
    const int tid = threadIdx.x, nq = tid & 15, kp = tid >> 4;
    LAS unsigned* T = (LAS unsigned*)lds;
#pragma unroll
    for (int pass = 0; pass < 2; ++pass)
#pragma unroll
        for (int j = 0; j < 4; ++j) T[(nq * 4 + j) * 68 + pass * 32 + kp] = cvt_pk_bf16(r[pass][0][j] * sc[pass][0], r[pass][1][j] * sc[pass][1]);
    __syncthreads();
#pragma unroll
    for (int i = 0; i < 2; ++i) {
        const int ch = tid + i * 512; const int n = ch >> 4, c16 = ch & 15;
        const u32x4 v = *(const LAS u32x4*)(T + n * 68 + c16 * 4);
        *(u32x4*)(d.dst + (size_t)(d.n0 + n) * d.dpitch + d.k0 + c16 * 8) = v;
    }
    __syncthreads();
}

__device__ void p0_prep(const Params& p, LAS unsigned char* lds) {
    const int tid = threadIdx.x, lane = tid & 63, wid = tid >> 6;
    bf16_t* hn = (bf16_t*)(p.ws + WS_HN);
    { float* s1 = (float*)(p.ws + WS_SSQ1); for (int i = blockIdx.x * 512 + tid; i < 2 * MP; i += gridDim.x * 512) s1[i] = 0.f; }
    constexpr int T_ALL = 212 * 16 + 32 * 32;
    {
        int t = blockIdx.x;
        TrTile dc = tr_desc(p, t < T_ALL ? t : 0);
        f32x4 rc[2][2]; float sc[2][2];
        if (t < T_ALL) tr_load(dc, rc, sc);
        while (t < T_ALL) {
            const int tn = t + gridDim.x;
            TrTile dn = tr_desc(p, tn < T_ALL ? tn : 0);
            f32x4 rn[2][2]; float sn[2][2];
            if (tn < T_ALL) tr_load(dn, rn, sn);
            tr_store(lds, dc, rc, sc);
            dc = dn; t = tn;
#pragma unroll
            for (int a = 0; a < 2; ++a)
#pragma unroll
                for (int b = 0; b < 2; ++b) { rc[a][b] = rn[a][b]; sc[a][b] = sn[a][b]; }
        }
    }
    const int gw = blockIdx.x * 8 + wid, nw = gridDim.x * 8;
    for (int r = gw; r < MP; r += nw) {
        bf16_t* o = hn + (size_t)r * DM;
        if (r >= ROW_END) {
#pragma unroll
            for (int i = 0; i < 8; ++i) *(u32x2*)(o + i * 256 + lane * 4) = (u32x2){0u, 0u};
            continue;
        }
        const float* src;
        if (r < ROW_S0) { const int bb = r / BROWS, q = r - bb * BROWS; src = q < NMETA ? p.meta + (size_t)q * DM : p.x_prompt + ((size_t)bb * SEQ + (q - NMETA)) * DM; }
        else src = p.x_sample + (size_t)(r - ROW_S0) * DM;
        f32x4 v[8]; float ss = 0.f;
#pragma unroll
        for (int i = 0; i < 8; ++i) { v[i] = *(const f32x4*)(src + i * 256 + lane * 4); ss += (v[i][0] * v[i][0] + v[i][1] * v[i][1]) + (v[i][2] * v[i][2] + v[i][3] * v[i][3]); }
        ss = wave_sum(ss);
        const float rs = __builtin_amdgcn_rsqf(ss * (1.0f / 2048.f) + EPS);
#pragma unroll
        for (int i = 0; i < 8; ++i) { const f32x4 w = *(const f32x4*)(p.norm_w + i * 256 + lane * 4);
            u32x2 pk; pk.x = cvt_pk_bf16(v[i][0] * rs * w[0], v[i][1] * rs * w[1]); pk.y = cvt_pk_bf16(v[i][2] * rs * w[2], v[i][3] * rs * w[3]);
            *(u32x2*)(o + i * 256 + lane * 4) = pk; }
    }
}

constexpr int PIT = 272;
constexpr int L_CS = 0, L_BS = 34816, L_BT = 69632, L_XT = 104448, L_SB = 121856, L_SC = 139264;
constexpr int F_DT = 0, F_ACS = 256, F_WV = 512, F_SSL = 768, F_AEND = 1024;

__device__ __forceinline__ void scan_load(const Params& p, int rb, int lmin, int h, float& d0, float& d1) {
    const int lane = threadIdx.x & 63; const float* dtv = (const float*)(p.ws + WS_DTV);
    const int l0 = 2 * lane, g0 = max(rb + l0, 0), g1 = max(rb + l0 + 1, 0);
    d0 = dtv[g0 * 32 + h]; d1 = dtv[g1 * 32 + h];
    d0 = l0 >= lmin ? d0 : 0.f; d1 = l0 + 1 >= lmin ? d1 : 0.f;
}
__device__ __forceinline__ void scan_finish(LAS float* sm, int buf, float d0, float d1, float a_neg) {
    const int lane = threadIdx.x & 63;
    const float x0 = d0 * a_neg, x1 = d1 * a_neg;
    float s = x0 + x1;
#pragma unroll
    for (int o = 1; o < 64; o <<= 1) { const float t = __shfl_up(s, o); if (lane >= o) s += t; }
    const float c1 = s, c0 = s - x1;
    const float aend = __shfl(s, 63);
    sm[F_DT + buf * 128 + 2 * lane] = d0; sm[F_DT + buf * 128 + 2 * lane + 1] = d1;
    sm[F_ACS + buf * 128 + 2 * lane] = c0; sm[F_ACS + buf * 128 + 2 * lane + 1] = c1;
    sm[F_WV + buf * 128 + 2 * lane] = d0 * __expf(aend - c0); sm[F_WV + buf * 128 + 2 * lane + 1] = d1 * __expf(aend - c1);
    if (lane == 0) sm[F_AEND + buf] = aend;
}

template <int NR, class Store>
__device__ __forceinline__ void conv_rows(const Params& p, int rb, int lmin, int l0, int pcol, int wcol, Store&& st) {
    const bf16_t* proj = (const bf16_t*)(p.ws + WS_PROJ);
    u32x4 raw[NR + 3];
#pragma unroll
    for (int i = 0; i < NR + 3; ++i) { const int l = l0 - 3 + i; const int g = max(rb + l, 0);
        raw[i] = *(const u32x4*)(proj + (size_t)g * NP + pcol);
        if (l < lmin) raw[i] = (u32x4){0u, 0u, 0u, 0u}; }
    float w[4][8], bias[8];
#pragma unroll
    for (int k = 0; k < 4; ++k) { const f32x4 a = *(const f32x4*)(p.conv_ssd_w + k * DXBC + wcol), b = *(const f32x4*)(p.conv_ssd_w + k * DXBC + wcol + 4);
        w[k][0] = a[0]; w[k][1] = a[1]; w[k][2] = a[2]; w[k][3] = a[3]; w[k][4] = b[0]; w[k][5] = b[1]; w[k][6] = b[2]; w[k][7] = b[3]; }
    { const f32x4 a = *(const f32x4*)(p.conv_ssd_b + wcol), b = *(const f32x4*)(p.conv_ssd_b + wcol + 4);
      bias[0] = a[0]; bias[1] = a[1]; bias[2] = a[2]; bias[3] = a[3]; bias[4] = b[0]; bias[5] = b[1]; bias[6] = b[2]; bias[7] = b[3]; }
    float h0[8], h1[8], h2[8], cur[8];
    unpack8(raw[0], h0); unpack8(raw[1], h1); unpack8(raw[2], h2);
#pragma unroll
    for (int i = 0; i < NR; ++i) {
        unpack8(raw[i + 3], cur);
        float o[8];
#pragma unroll
        for (int j = 0; j < 8; ++j) { const float a = bias[j] + w[0][j] * h0[j] + w[1][j] * h1[j] + w[2][j] * h2[j] + w[3][j] * cur[j]; o[j] = silu_f(a); }
        st(i, o);
#pragma unroll
        for (int j = 0; j < 8; ++j) { h0[j] = h1[j]; h1[j] = h2[j]; h2[j] = cur[j]; }
    }
}

__device__ void conv_pre(const Params& p) {
    const bf16_t* proj = (const bf16_t*)(p.ws + WS_PROJ);
    bf16_t* xc = (bf16_t*)(p.ws + WS_XC); float* dtv = (float*)(p.ws + WS_DTV);
    const int gt = blockIdx.x * 512 + threadIdx.x, nthr = gridDim.x * 512;
    for (int T = gt; T < (ROW_S0 / 4) * 384; T += nthr) {
        const int cgp = T % 384, rg = T / 384; const int R0 = rg * 4, col = cgp * 8;
        const int lmin = (R0 % BROWS) != 0 ? -3 : 0;
        conv_rows<4>(p, R0, lmin, 0, CX + col, col, [&](int i, const float (&o)[8]) {
            u32x4 pk; pk.x = cvt_pk_bf16(o[0], o[1]); pk.y = cvt_pk_bf16(o[2], o[3]); pk.z = cvt_pk_bf16(o[4], o[5]); pk.w = cvt_pk_bf16(o[6], o[7]);
            *(u32x4*)(xc + (size_t)(R0 + i) * DXBC + col) = pk; });
    }
    for (int T = gt; T < ROW_S0 * 32; T += nthr) { const int R = T >> 5, h = T & 31; dtv[T] = softplus_f(bf1(proj[(size_t)R * NP + CDT + h]) + p.dt_bias[h]); }
}

__device__ __forceinline__ int swz(int row, int l) { return row * PIT + ((((l >> 3) ^ (row >> 3)) & 15) << 4) + ((l & 7) << 1); }

__device__ void ssd_item(const Params& p, LAS unsigned char* lds, int item) {
    const int tid = threadIdx.x, lane = tid & 63, w = __builtin_amdgcn_readfirstlane(tid >> 6), r = lane & 31, hh = lane >> 5;
    const int pair = (item & 7) + 8 * (item >> 6), hg = (item >> 3) & 7;
    const int b = pair >> 2, g = pair & 3, h = g * 8 + hg;
    const bf16_t* proj = (const bf16_t*)(p.ws + WS_PROJ);
    const bf16_t* xc = (const bf16_t*)(p.ws + WS_XC);
    bf16_t* ymix = (bf16_t*)(p.ws + WS_YMIX);
    float* ssq1 = (float*)(p.ws + WS_SSQ1);
    LAS float* sm = (LAS float*)(lds + L_SC);
    const float a_neg = -__expf(p.a_log[h]), Dh = p.d_skip[h];
    const int l0 = (((tid >> 2) & 3) | ((tid >> 6) << 2)) * 4, n0 = ((tid & 3) | (((tid >> 4) & 3) << 2)) * 8; const int xl0 = (tid >> 3) * 2, p0 = (tid & 7) * 8;
    const int colB = 2048 + g * 128 + n0, colC = colB + 512, colX = h * 64 + p0;
    u32x4 pB[4], pC[4], pX[2];
#define SSD_PREFETCH(RB) do { \
        _Pragma("unroll") for (int i = 0; i < 4; ++i) { const size_t gg = (size_t)max((RB) + l0 + i, 0) * DXBC; pB[i] = *(const u32x4*)(xc + gg + colB); pC[i] = *(const u32x4*)(xc + gg + colC); } \
        _Pragma("unroll") for (int i = 0; i < 2; ++i) { const size_t gg = (size_t)max((RB) + xl0 + i, 0) * DXBC; pX[i] = *(const u32x4*)(xc + gg + colX); } } while (0)
    SSD_PREFETCH(b * BROWS - 112);
    for (int i = tid; i < 17408 / 4; i += 512) ((LAS unsigned*)(lds + L_SB))[i] = 0u;
    if (w == 1) { float d0, d1; scan_load(p, b * BROWS - 112, 112, h, d0, d1); scan_finish(sm, 0, d0, d1, a_neg); }
    f32x16 accS;
#pragma unroll
    for (int i = 0; i < 16; ++i) accS[i] = 0.f;
    const int lt = w < 4 ? (w >> 1) : 3 - ((w - 4) >> 1), pt = w & 1, pt2 = w >> 2, nt = w & 3;
    __syncthreads();
    for (int c = 0; c <= 16; ++c) {
        const int buf = c & 1; const int rb = b * BROWS + NMETA + (c - 1) * 128, lmin = (c == 0) ? 112 : -3; const int base = b * SEQ + (c - 1) * 128;
        {
            unsigned bt[8][2], xt[8];
#pragma unroll
            for (int i = 0; i < 4; ++i) {
                const bool valid = (l0 + i) >= lmin;
                const u32x4 vb = valid ? pB[i] : (u32x4){0u, 0u, 0u, 0u}, vc = valid ? pC[i] : (u32x4){0u, 0u, 0u, 0u};
                *(LAS u32x4*)(lds + L_BS + (l0 + i) * PIT + n0 * 2) = vb;
                *(LAS u32x4*)(lds + L_CS + (l0 + i) * PIT + n0 * 2) = vc;
                float f[8]; unpack8(vb, f);
                const float wl = sm[F_WV + buf * 128 + l0 + i];
#pragma unroll
                for (int j = 0; j < 8; ++j) { const unsigned q = cvt_pk_bf16(f[j] * wl, 0.f);
                    if (i & 1) bt[j][i >> 1] |= q << 16; else bt[j][i >> 1] = q & 0xffffu; }
            }
#pragma unroll
            for (int j = 0; j < 8; ++j) *(LAS u32x2*)(lds + L_BT + swz(n0 + j, l0)) = (u32x2){bt[j][0], bt[j][1]};
#pragma unroll
            for (int i = 0; i < 2; ++i) {
                const bool valid = (xl0 + i) >= lmin;
                const u32x4 vx = valid ? pX[i] : (u32x4){0u, 0u, 0u, 0u};
                const unsigned ws4[4] = {vx.x, vx.y, vx.z, vx.w};
#pragma unroll
                for (int j = 0; j < 8; ++j) { const unsigned q = (j & 1) ? (ws4[j >> 1] >> 16) : (ws4[j >> 1] & 0xffffu);
                    if (i & 1) xt[j] |= q << 16; else xt[j] = q; }
            }
#pragma unroll
            for (int j = 0; j < 8; ++j) *(LAS unsigned*)(lds + L_XT + (p0 + j) * PIT + xl0 * 2) = xt[j];
        }
        u32x2 zr[4];
        if (c > 0) {
#pragma unroll
            for (int k = 0; k < 4; ++k) zr[k] = *(const u32x2*)(proj + (size_t)(rb + lt * 32 + r) * NP + CZ + h * 64 + pt * 32 + 8 * k + 4 * hh);
        }
        float sd0 = 0.f, sd1 = 0.f;
        if (w == 1 && c < 16) scan_load(p, rb + 128, -3, h, sd0, sd1);
        if (c < 16) SSD_PREFETCH(rb + 128);
        __syncthreads();
        f32x16 aD, aO;
#pragma unroll
        for (int i = 0; i < 16; ++i) { aD[i] = 0.f; aO[i] = 0.f; }
        if (c > 0) {
            const int lrow = lt * 32 + r; const float acl = sm[F_ACS + buf * 128 + lrow];
            for (int st = 0; st <= lt; ++st) {
                f32x16 cb;
#pragma unroll
                for (int i = 0; i < 16; ++i) cb[i] = 0.f;
#pragma unroll
                for (int ks = 0; ks < 8; ++ks) {
                    const bf16x8 a = *(const LAS bf16x8*)(lds + L_BS + (st * 32 + r) * PIT + (ks * 16 + hh * 8) * 2);
                    const bf16x8 bc = *(const LAS bf16x8*)(lds + L_CS + lrow * PIT + (ks * 16 + hh * 8) * 2);
                    cb = __builtin_amdgcn_mfma_f32_32x32x16_bf16(a, bc, cb, 0, 0, 0);
                }
                float mv[16];
#pragma unroll
                for (int g4 = 0; g4 < 4; ++g4) {
                    const int sb = st * 32 + 8 * g4 + 4 * hh;
                    const f32x4 as = *(const LAS f32x4*)(sm + F_ACS + buf * 128 + sb), dd = *(const LAS f32x4*)(sm + F_DT + buf * 128 + sb);
#pragma unroll
                    for (int j = 0; j < 4; ++j) mv[4 * g4 + j] = (sb + j <= lrow) ? cb[4 * g4 + j] * __expf(acl - as[j]) * dd[j] : 0.f;
                }
#pragma unroll
                for (int sp = 0; sp < 2; ++sp) {
                    u32x4 bp; bp.x = cvt_pk_bf16(mv[8 * sp + 0], mv[8 * sp + 1]); bp.y = cvt_pk_bf16(mv[8 * sp + 2], mv[8 * sp + 3]);
                    bp.z = cvt_pk_bf16(mv[8 * sp + 4], mv[8 * sp + 5]); bp.w = cvt_pk_bf16(mv[8 * sp + 6], mv[8 * sp + 7]);
                    const u32x2 xlo = *(const LAS u32x2*)(lds + L_XT + (pt * 32 + r) * PIT + (st * 32 + 16 * sp + 4 * hh) * 2);
                    const u32x2 xhi = *(const LAS u32x2*)(lds + L_XT + (pt * 32 + r) * PIT + (st * 32 + 16 * sp + 8 + 4 * hh) * 2);
                    const u32x4 ap = (u32x4){xlo.x, xlo.y, xhi.x, xhi.y};
                    aD = __builtin_amdgcn_mfma_f32_32x32x16_bf16(__builtin_bit_cast(bf16x8, ap), __builtin_bit_cast(bf16x8, bp), aD, 0, 0, 0);
                }
            }
#pragma unroll
            for (int ks = 0; ks < 8; ++ks) {
                const bf16x8 a = *(const LAS bf16x8*)(lds + L_CS + lrow * PIT + (ks * 16 + hh * 8) * 2);
                const bf16x8 bs = *(const LAS bf16x8*)(lds + L_SB + (pt * 32 + r) * PIT + (ks * 16 + hh * 8) * 2);
                aO = __builtin_amdgcn_mfma_f32_32x32x16_bf16(bs, a, aO, 0, 0, 0);
            }
        }
        {
            const float dec = __expf(sm[F_AEND + buf]);
#pragma unroll
            for (int i = 0; i < 16; ++i) accS[i] *= dec;
#pragma unroll
            for (int ks = 0; ks < 8; ++ks) {
                const bf16x8 a = *(const LAS bf16x8*)(lds + L_XT + (pt2 * 32 + r) * PIT + (ks * 16 + hh * 8) * 2);
                const bf16x8 bb = *(const LAS bf16x8*)(lds + L_BT + swz(nt * 32 + r, ks * 16 + hh * 8));
                accS = __builtin_amdgcn_mfma_f32_32x32x16_bf16(a, bb, accS, 0, 0, 0);
            }
        }
        if (w == 1 && c < 16) scan_finish(sm, buf ^ 1, sd0, sd1, a_neg);
        if (c > 0) {
            const int l = lt * 32 + r; const float eacs = __expf(sm[F_ACS + buf * 128 + l]);
            float q = 0.f;
#pragma unroll
            for (int k = 0; k < 4; ++k) {
                const int pl = pt * 32 + 8 * k + 4 * hh;
                const float z4[4] = {bf_lo(zr[k].x), bf_hi(zr[k].x), bf_lo(zr[k].y), bf_hi(zr[k].y)};
                float gv[4];
#pragma unroll
                for (int j = 0; j < 4; ++j) { const int i = 4 * k + j;
                    const float xv = bf1(*(const LAS bf16_t*)(lds + L_XT + (pl + j) * PIT + l * 2));
                    const float y = aD[i] + eacs * aO[i] + Dh * xv;
                    gv[j] = y * silu_f(z4[j]); q += gv[j] * gv[j]; }
                u32x2 pk; pk.x = cvt_pk_bf16(gv[0], gv[1]); pk.y = cvt_pk_bf16(gv[2], gv[3]);
                *(u32x2*)(ymix + (size_t)(base + l) * KO + h * 64 + pl) = pk;
            }
            q += __shfl_xor(q, 32);
            if (hh == 0) sm[F_SSL + pt * 128 + l] = q;
        }
        __syncthreads();
        if (c > 0 && tid < 128) unsafeAtomicAdd(ssq1 + base + tid, sm[F_SSL + tid] + sm[F_SSL + 128 + tid]);
#pragma unroll
        for (int i = 0; i < 16; ++i) { const int pp = pt2 * 32 + (i & 3) + 8 * (i >> 2) + 4 * hh;
            *(LAS bf16_t*)(lds + L_SB + pp * PIT + (nt * 32 + r) * 2) = (bf16_t)(cvt_pk_bf16(accS[i], 0.f) & 0xffffu); }
    }
#undef SSD_PREFETCH
    float* so = p.out + O_SSMP + ((size_t)(b * 32 + h) * 64) * 128;
#pragma unroll
    for (int i = 0; i < 16; ++i) { const int pp = pt2 * 32 + (i & 3) + 8 * (i >> 2) + 4 * hh; so[(size_t)pp * 128 + nt * 32 + r] = accS[i]; }
    __syncthreads();
}

__device__ __forceinline__ float block_sum(float v, LAS float* red) {
    v = wave_sum(v);
    __syncthreads();
    if ((threadIdx.x & 63) == 0) red[threadIdx.x >> 6] = v;
    __syncthreads();
    float s = 0.f;
#pragma unroll
    for (int i = 0; i < 8; ++i) s += red[i];
    return s;
}

__device__ void decode_item(const Params& p, LAS unsigned char* lds, int j) {
    const int tid = threadIdx.x, lane = tid & 63, w = tid >> 6;
    const bf16_t* proj = (const bf16_t*)(p.ws + WS_PROJ);
    bf16_t* ymix = (bf16_t*)(p.ws + WS_YMIX);
    const int R = YROW_S0 + j;
    const bf16_t* prow = proj + (size_t)(ROW_S0 + j) * NP;
    LAS float* xc = (LAS float*)lds;
    LAS float* yv = xc + 3072;
    LAS float* dts = yv + 2048;
    LAS float* dAs = dts + 32;
    LAS float* red = dAs + 32;
    {
        const float* cs = p.state_ssd_conv + (size_t)j * 3 * DXBC; float* co = p.out + O_CSS + (size_t)j * 3 * DXBC;
#pragma unroll
        for (int k = 0; k < 6; ++k) { const int col = tid + 512 * k;
            const float raw = bf1(prow[CX + col]); const float s0 = cs[col], s1 = cs[DXBC + col], s2 = cs[2 * DXBC + col];
            const float a = p.conv_ssd_b[col] + p.conv_ssd_w[col] * s0 + p.conv_ssd_w[DXBC + col] * s1 + p.conv_ssd_w[2 * DXBC + col] * s2 + p.conv_ssd_w[3 * DXBC + col] * raw;
            xc[col] = silu_f(a);
            co[col] = s1; co[DXBC + col] = s2; co[2 * DXBC + col] = raw; }
        if (tid < 32) { const float d = softplus_f(bf1(prow[CDT + tid]) + p.dt_bias[tid]); dts[tid] = d; dAs[tid] = __expf(d * (-__expf(p.a_log[tid]))); }
    }
    __syncthreads();
    {
        const int g = w >> 1, q = lane & 31, half = lane >> 5;
        const f32x4 Bq = *(const LAS f32x4*)(xc + 2048 + g * 128 + 4 * q), Cq = *(const LAS f32x4*)(xc + 2560 + g * 128 + 4 * q);
        const float* sin = p.state_ssm + (size_t)j * 32 * 64 * 128; float* sout = p.out + O_SSMS + (size_t)j * 32 * 64 * 128;
        const int b4 = (lane >> 4) & 1, b3 = (lane >> 3) & 1;
#define DEC_LOAD(buf, bi) do { const int h_ = 4 * w + ((bi) >> 1), it0_ = ((bi) & 1) * 16; \
            _Pragma("unroll") for (int u = 0; u < 16; ++u) buf[u] = __builtin_nontemporal_load((const f32x4*)(sin + ((size_t)h_ * 64 + 2 * (it0_ + u) + half) * 128 + 4 * q)); } while (0)
#define DEC_PROC(buf, bi) do { const int h_ = 4 * w + ((bi) >> 1), it0_ = ((bi) & 1) * 16; const float dtv = dts[h_], dA = dAs[h_], Dh = p.d_skip[h_]; \
            float yp[16]; \
            _Pragma("unroll") for (int u = 0; u < 16; ++u) { const int pp = 2 * (it0_ + u) + half; const float xd = xc[h_ * 64 + pp] * dtv; \
                const f32x4 sn = buf[u] * dA + Bq * xd; \
                __builtin_nontemporal_store(sn, (f32x4*)(sout + ((size_t)h_ * 64 + pp) * 128 + 4 * q)); \
                yp[u] = (sn[0] * Cq[0] + sn[1] * Cq[1]) + (sn[2] * Cq[2] + sn[3] * Cq[3]); } \
            float a8[8], a4[4]; \
            _Pragma("unroll") for (int k = 0; k < 8; ++k) { const float snd = b4 ? yp[k] : yp[8 + k], kp = b4 ? yp[8 + k] : yp[k]; a8[k] = kp + __shfl_xor(snd, 16); } \
            _Pragma("unroll") for (int k = 0; k < 4; ++k) { const float snd = b3 ? a8[k] : a8[4 + k], kp = b3 ? a8[4 + k] : a8[k]; a4[k] = sum8_dpp(kp + __shfl_xor(snd, 8)); } \
            if ((lane & 7) == 0) { _Pragma("unroll") for (int k = 0; k < 4; ++k) { const int pp = 2 * (it0_ + 8 * b4 + 4 * b3 + k) + half; yv[h_ * 64 + pp] = a4[k] + Dh * xc[h_ * 64 + pp]; } } } while (0)
        f32x4 bufA[16], bufB[16];
        DEC_LOAD(bufA, 0);
        for (int bi = 0; bi < 8; bi += 2) {
            DEC_LOAD(bufB, bi + 1);
            DEC_PROC(bufA, bi);
            if (bi + 2 < 8) DEC_LOAD(bufA, bi + 2);
            DEC_PROC(bufB, bi + 1);
        }
#undef DEC_LOAD
#undef DEC_PROC
    }
    __syncthreads();
    {
        const int c0 = tid * 4; const u32x2 zz = *(const u32x2*)(prow + CZ + c0);
        const float z[4] = {bf_lo(zz.x), bf_hi(zz.x), bf_lo(zz.y), bf_hi(zz.y)};
        float gv[4]; float ss = 0.f;
#pragma unroll
        for (int k = 0; k < 4; ++k) { gv[k] = yv[c0 + k] * silu_f(z[k]); ss += gv[k] * gv[k]; }
        const float tot = block_sum(ss, red); const float rs = __builtin_amdgcn_rsqf(tot * (1.0f / 2048.f) + EPS);
        u32x2 pk; pk.x = cvt_pk_bf16(gv[0] * rs, gv[1] * rs); pk.y = cvt_pk_bf16(gv[2] * rs, gv[3] * rs);
        *(u32x2*)(ymix + (size_t)R * KO + c0) = pk;
    }
    {
        const int c0 = tid * 4;
        const u32x2 zz = *(const u32x2*)(prow + CZS + c0), bb = *(const u32x2*)(prow + CBS + c0), cc = *(const u32x2*)(prow + CCS + c0), hh4 = *(const u32x2*)(prow + CHS + c0);
        const float z[4] = {bf_lo(zz.x), bf_hi(zz.x), bf_lo(zz.y), bf_hi(zz.y)}, bv[4] = {bf_lo(bb.x), bf_hi(bb.x), bf_lo(bb.y), bf_hi(bb.y)};
        const float cv[4] = {bf_lo(cc.x), bf_hi(cc.x), bf_lo(cc.y), bf_hi(cc.y)}, hv[4] = {bf_lo(hh4.x), bf_hi(hh4.x), bf_lo(hh4.y), bf_hi(hh4.y)};
        const float* ss_in = p.state_short_conv + (size_t)j * 2 * DM; float* so = p.out + O_SCS + (size_t)j * 2 * DM;
        const f32x4 s0 = *(const f32x4*)(ss_in + c0), s1 = *(const f32x4*)(ss_in + DM + c0);
        const f32x4 w0 = *(const f32x4*)(p.conv_sc_w + c0), w1 = *(const f32x4*)(p.conv_sc_w + DM + c0), w2 = *(const f32x4*)(p.conv_sc_w + 2 * DM + c0);
        float y[4]; f32x4 vn; float ss = 0.f;
#pragma unroll
        for (int k = 0; k < 4; ++k) { const float v = cv[k] * hv[k]; vn[k] = v; y[k] = bv[k] * (w0[k] * s0[k] + w1[k] * s1[k] + w2[k] * v) * silu_f(z[k]); ss += y[k] * y[k]; }
        *(f32x4*)(so + c0) = s1; *(f32x4*)(so + DM + c0) = vn;
        const float tot = block_sum(ss, red); const float rs = __builtin_amdgcn_rsqf(tot * (1.0f / 2048.f) + EPS);
        u32x2 pk; pk.x = cvt_pk_bf16(y[0] * rs, y[1] * rs); pk.y = cvt_pk_bf16(y[2] * rs, y[3] * rs);
        *(u32x2*)(ymix + (size_t)R * KO + 2048 + c0) = pk;
    }
    __syncthreads();
}

__device__ void sc_item(const Params& p, int item) {
    const int tid = threadIdx.x, lane = tid & 63, w = tid >> 6;
    const bf16_t* proj = (const bf16_t*)(p.ws + WS_PROJ);
    bf16_t* ymix = (bf16_t*)(p.ws + WS_YMIX);
    float* ssq2 = (float*)(p.ws + WS_SSQ2);
    const int t0 = item * 64; const int b = t0 >> 11, tpos = t0 & 2047;
    const int pr0 = t0 + NMETA * (b + 1);
    const int c0 = w * 256 + lane * 4;
    const f32x4 w0 = *(const f32x4*)(p.conv_sc_w + c0), w1 = *(const f32x4*)(p.conv_sc_w + DM + c0), w2 = *(const f32x4*)(p.conv_sc_w + 2 * DM + c0);
    f32x4 vm2, vm1;
    {
        const int g2 = pr0 - 2, g1 = pr0 - 1;
        const u32x2 c2 = *(const u32x2*)(proj + (size_t)g2 * NP + CCS + c0), h2 = *(const u32x2*)(proj + (size_t)g2 * NP + CHS + c0);
        const u32x2 c1 = *(const u32x2*)(proj + (size_t)g1 * NP + CCS + c0), h1 = *(const u32x2*)(proj + (size_t)g1 * NP + CHS + c0);
        vm2 = (f32x4){bf_lo(c2.x) * bf_lo(h2.x), bf_hi(c2.x) * bf_hi(h2.x), bf_lo(c2.y) * bf_lo(h2.y), bf_hi(c2.y) * bf_hi(h2.y)};
        vm1 = (f32x4){bf_lo(c1.x) * bf_lo(h1.x), bf_hi(c1.x) * bf_hi(h1.x), bf_lo(c1.y) * bf_lo(h1.y), bf_hi(c1.y) * bf_hi(h1.y)};
    }
    const int b5 = lane >> 5, b4 = (lane >> 4) & 1, b3 = (lane >> 3) & 1;
#define SC_LOAD(Z, B, C, H, i0_) do { _Pragma("unroll") for (int u = 0; u < 8; ++u) { const bf16_t* pr = proj + (size_t)(pr0 + (i0_) + u) * NP + c0; \
            Z[u] = *(const u32x2*)(pr + CZS); B[u] = *(const u32x2*)(pr + CBS); C[u] = *(const u32x2*)(pr + CCS); H[u] = *(const u32x2*)(pr + CHS); } } while (0)
#define SC_PROC(Z, B, C, H, i0_) do { float ssr[8]; \
        _Pragma("unroll") for (int u = 0; u < 8; ++u) { const int t = t0 + (i0_) + u; \
            const f32x4 v = (f32x4){bf_lo(C[u].x) * bf_lo(H[u].x), bf_hi(C[u].x) * bf_hi(H[u].x), bf_lo(C[u].y) * bf_lo(H[u].y), bf_hi(C[u].y) * bf_hi(H[u].y)}; \
            const f32x4 z = (f32x4){bf_lo(Z[u].x), bf_hi(Z[u].x), bf_lo(Z[u].y), bf_hi(Z[u].y)}; \
            const f32x4 bv = (f32x4){bf_lo(B[u].x), bf_hi(B[u].x), bf_lo(B[u].y), bf_hi(B[u].y)}; \
            const f32x4 cv = w0 * vm2 + w1 * vm1 + w2 * v; \
            f32x4 y; float ss = 0.f; \
            _Pragma("unroll") for (int k = 0; k < 4; ++k) { y[k] = bv[k] * cv[k] * silu_f(z[k]); ss += y[k] * y[k]; } \
            ssr[u] = ss; \
            u32x2 pk; pk.x = cvt_pk_bf16(y[0], y[1]); pk.y = cvt_pk_bf16(y[2], y[3]); \
            *(u32x2*)(ymix + (size_t)t * KO + 2048 + c0) = pk; \
            if ((t & 2047) == 2047) { float* so = p.out + O_SCP + (size_t)b * 2 * DM; *(f32x4*)(so + c0) = vm1; *(f32x4*)(so + DM + c0) = v; } \
            vm2 = vm1; vm1 = v; } \
        float s4[4], s2[2]; \
        _Pragma("unroll") for (int k = 0; k < 4; ++k) { const float snd = b5 ? ssr[k] : ssr[4 + k], kp = b5 ? ssr[4 + k] : ssr[k]; s4[k] = kp + __shfl_xor(snd, 32); } \
        _Pragma("unroll") for (int k = 0; k < 2; ++k) { const float snd = b4 ? s4[k] : s4[2 + k], kp = b4 ? s4[2 + k] : s4[k]; s2[k] = kp + __shfl_xor(snd, 16); } \
        float s1; { const float snd = b3 ? s2[0] : s2[1], kp = b3 ? s2[1] : s2[0]; s1 = sum8_dpp(kp + __shfl_xor(snd, 8)); } \
        if ((lane & 7) == 0) unsafeAtomicAdd(ssq2 + t0 + (i0_) + 4 * b5 + 2 * b4 + b3, s1); } while (0)
    u32x2 zA[8], bA[8], cA[8], hA[8], zB[8], bB[8], cB[8], hB[8];
    SC_LOAD(zA, bA, cA, hA, 0);
    for (int i0 = 0; i0 < 64; i0 += 16) {
        SC_LOAD(zB, bB, cB, hB, i0 + 8);
        SC_PROC(zA, bA, cA, hA, i0);
        if (i0 + 16 < 64) SC_LOAD(zA, bA, cA, hA, i0 + 16);
        SC_PROC(zB, bB, cB, hB, i0 + 8);
    }
#undef SC_LOAD
#undef SC_PROC
    if (tpos == 2048 - 64) {
        float* co = p.out + O_CSP + (size_t)b * 3 * DXBC;
        for (int i = tid; i < 3 * DXBC; i += 512) { const int rr = i / DXBC, col = i - rr * DXBC; co[i] = bf1(proj[(size_t)(b * BROWS + NMETA + 2045 + rr) * NP + CX + col]); }
    }
}

__device__ void sample_outproj(const Params& p, LAS unsigned char* lds) {
    const int tid = threadIdx.x, lane = tid & 63, w = tid >> 6;
    const bf16_t* ymix = (const bf16_t*)(p.ws + WS_YMIX); const bf16_t* WoutT = (const bf16_t*)(p.ws + WS_WOUT);
    const int strip = blockIdx.x >> 1, rhalf = blockIdx.x & 1; const int n0 = strip * 16;
    const int rg = w & 3, kh = w >> 2;
    const int fr = lane & 15, fq = lane >> 4;
    const bf16_t* ap = ymix + (size_t)(YROW_S0 + rhalf * 64 + rg * 16 + fr) * KO + kh * 2048 + fq * 8;
    const bf16_t* bp = WoutT + (size_t)(n0 + fr) * KO + kh * 2048 + fq * 8;
    f32x4 acc = (f32x4){0.f, 0.f, 0.f, 0.f};
    for (int ks = 0; ks < 64; ks += 16) {
        bf16x8 a[16], b[16];
#pragma unroll
        for (int u = 0; u < 16; ++u) { a[u] = *(const bf16x8*)(ap + (ks + u) * 32); b[u] = *(const bf16x8*)(bp + (ks + u) * 32); }
#pragma unroll
        for (int u = 0; u < 16; ++u) acc = __builtin_amdgcn_mfma_f32_16x16x32_bf16(a[u], b[u], acc, 0, 0, 0);
    }
    LAS f32x4* ex = (LAS f32x4*)lds;
    if (kh == 1) ex[rg * 64 + lane] = acc;
    __syncthreads();
    if (kh == 0) {
        acc += ex[rg * 64 + lane];
#pragma unroll
        for (int i = 0; i < 4; ++i) { const int srow = rhalf * 64 + rg * 16 + fq * 4 + i; p.out[O_YS + (size_t)srow * DM + n0 + fr] = acc[i]; }
    }
    __syncthreads();
}

__device__ void p4_final(const Params& p) {
    const int tid = threadIdx.x, lane = tid & 63, wid = tid >> 6;
    const int gw = blockIdx.x * 8 + wid, nw = gridDim.x * 8;
    f32x4 fw[8];
#pragma unroll
    for (int i = 0; i < 8; ++i) fw[i] = *(const f32x4*)(p.final_norm_w + i * 256 + lane * 4);
    for (int r = gw; r < 8192 + 128; r += nw) {
        float* o = r < 8192 ? p.out + O_YP + (size_t)r * DM : p.out + O_YS + (size_t)(r - 8192) * DM;
        const float* x = r < 8192 ? p.x_prompt + (size_t)r * DM : p.x_sample + (size_t)(r - 8192) * DM;
        f32x4 v[8]; float ss = 0.f;
#pragma unroll
        for (int i = 0; i < 8; ++i) { const f32x4 a = *(const f32x4*)(o + i * 256 + lane * 4), b = __builtin_nontemporal_load((const f32x4*)(x + i * 256 + lane * 4)); v[i] = a + b;
            ss += (v[i][0] * v[i][0] + v[i][1] * v[i][1]) + (v[i][2] * v[i][2] + v[i][3] * v[i][3]); }
        ss = wave_sum(ss);
        const float rs = __builtin_amdgcn_rsqf(ss * (1.0f / 2048.f) + EPS);
#pragma unroll
        for (int i = 0; i < 8; ++i) __builtin_nontemporal_store(v[i] * rs * fw[i], (f32x4*)(o + i * 256 + lane * 4));
    }
}

#define XB_TMO      128
#define XB_XCNT(j)  (256  + 64 * (j))
#define XB_XSUB(j)  (1280 + 64 * (j))
#define XB_XGEN(j)  (2304 + 64 * (j))
#define XB_TOP      3328
#define XB_TOPGEN   3392
#define XCD_BAR_WORDS 3456
#define XB_SPIN_CAP (1u << 18)
__device__ __forceinline__ unsigned xb_ld(unsigned* p)              { return __hip_atomic_load(p, __ATOMIC_RELAXED, __HIP_MEMORY_SCOPE_AGENT); }
__device__ __forceinline__ unsigned xb_add(unsigned* p, unsigned v) { return __hip_atomic_fetch_add(p, v, __ATOMIC_RELAXED, __HIP_MEMORY_SCOPE_AGENT); }
__device__ __forceinline__ unsigned xb_xcc_id() { return (unsigned)__builtin_amdgcn_s_getreg((3 << 11) | 20) & 0xFu; }
#define XB_SPIN(cond, bar) do { unsigned _sp = 0; while (cond) { __builtin_amdgcn_s_sleep(1); \
    if ((++_sp & 255u) == 0u) { if (xb_ld(&(bar)[XB_TMO])) break; if (_sp > XB_SPIN_CAP) { atomicAdd(&(bar)[XB_TMO], 1u); break; } } } } while (0)
struct XcdBarrier { unsigned* bar; unsigned x; volatile LAS unsigned* st; };
__device__ __forceinline__ XcdBarrier xcd_barrier_post(unsigned* bar, volatile LAS unsigned* st) {
    XcdBarrier b; b.bar = bar; b.x = xb_xcc_id(); b.st = st;
    if (threadIdx.x == 0) (void)xb_add(&bar[XB_XCNT(b.x)], 1u);
    return b;
}
__device__ __forceinline__ void xcd_barrier_complete(unsigned* bar, unsigned x, unsigned& nloc, unsigned& nx) {
    const unsigned G = gridDim.x * gridDim.y * gridDim.z;
    unsigned sum, cnt, mine, sp = 0u;
    for (;;) {
        sum = 0u; cnt = 0u; mine = 0u;
#pragma unroll
        for (unsigned j = 0; j < 16; ++j) { const unsigned c = xb_ld(&bar[XB_XCNT(j)]); sum += c; cnt += (c > 0u) ? 1u : 0u; mine = (j == x) ? c : mine; }
        if (sum == G) break;
        __builtin_amdgcn_s_sleep(1);
        if ((++sp & 255u) == 0u) { if (xb_ld(&bar[XB_TMO])) break; if (sp > XB_SPIN_CAP) { atomicAdd(&bar[XB_TMO], 1u); break; } }
    }
    nloc = mine > 0u ? mine : 1u; nx = cnt > 0u ? cnt : 1u;
}
__device__ __forceinline__ void xcd_barrier(const XcdBarrier& b) {
    asm volatile("s_waitcnt vmcnt(0)" ::: "memory");
    __syncthreads();
    if (threadIdx.x == 0) {
        unsigned* bar = b.bar;
        __builtin_amdgcn_s_waitcnt(0);
        unsigned nloc = b.st[0], nx = b.st[1];
        if (nloc == 0u) { xcd_barrier_complete(bar, b.x, nloc, nx); b.st[0] = nloc; b.st[1] = nx; }
        const unsigned old = xb_add(&bar[XB_XSUB(b.x)], 1u);
        const unsigned gen = old / nloc;
        if (old + 1u == (gen + 1u) * nloc) {
            __builtin_amdgcn_fence(__ATOMIC_RELEASE, "agent");
            asm volatile("s_waitcnt vmcnt(0)" ::: "memory");
            const unsigned og = xb_add(&bar[XB_TOP], 1u);
            const unsigned tg = og / nx;
            if (og + 1u == (tg + 1u) * nx) xb_add(&bar[XB_TOPGEN], 1u);
            else XB_SPIN(xb_ld(&bar[XB_TOPGEN]) == tg, bar);
            __builtin_amdgcn_fence(__ATOMIC_ACQUIRE, "agent");
            xb_add(&bar[XB_XGEN(b.x)], 1u);
            asm volatile("s_waitcnt vmcnt(0)" ::: "memory");
        } else {
            XB_SPIN(xb_ld(&bar[XB_XGEN(b.x)]) == gen, bar);
            __builtin_amdgcn_fence(__ATOMIC_ACQUIRE, "agent");
            asm volatile("s_waitcnt vmcnt(0)" ::: "memory");
        }
    }
    __syncthreads();
}

__global__ void __launch_bounds__(512, 2) hymba_fwd(Params p) {
    extern __shared__ __attribute__((aligned(16))) unsigned char lds_raw[];
    LAS unsigned char* lds = (LAS unsigned char*)lds_raw;
    cg::grid_group grid = cg::this_grid();
    const int lo = p.ph_lo, hi = p.ph_hi;
#ifdef ONLY
#define IN(k) ((k) == ONLY && lo <= (k) && (k) < hi)
#else
#define IN(k) (lo <= (k) && (k) < hi)
#endif
#define SEAM(k) do { if (IN(k) && IN((k) + 1)) xcd_barrier(xb); } while (0)
    unsigned* barw = (unsigned*)(p.ws + WS_BAR);
    XcdBarrier xb; xb.bar = barw; xb.x = 0; xb.st = (volatile LAS unsigned*)(lds + LDS_BYTES - 16);
    if (IN(0)) {
        if (blockIdx.x == 0) for (int i = threadIdx.x; i < 3456; i += 512) barw[i] = 0u;
        p0_prep(p, lds);
    }
    if (IN(0) && IN(1)) {
        grid.sync();
        if (threadIdx.x < 4) ((volatile LAS unsigned*)(lds + LDS_BYTES - 16))[threadIdx.x] = 0u;
        __syncthreads();
        xb = xcd_barrier_post(barw, (volatile LAS unsigned*)(lds + LDS_BYTES - 16));
    }
    if (IN(1)) {
        pg8::Gemm g{(const bf16_t*)(p.ws + WS_HN), (const bf16_t*)(p.ws + WS_WIN), MP, NP, DM};
        pg8::StaticOrder S; S.init(MP, NP, (int)gridDim.x, (int)blockIdx.x);
        pg8::EpiProj E{(bf16_t*)(p.ws + WS_PROJ), NP};
        pg8::gemm_phase<pg8::EpiProj>(lds, g, S, E);
    }
    SEAM(1);
    if (IN(2)) conv_pre(p);
    SEAM(2);
    if (IN(3)) {
        const int it = blockIdx.x;
        if (it < 128) { if (!(p.flags & 8)) ssd_item(p, lds, it); }
        else { if (!(p.flags & 4)) decode_item(p, lds, it - 128); if (!(p.flags & 16)) sc_item(p, it - 128); }
    }
    SEAM(3);
    if (IN(4)) {
        if (!(p.flags & 1)) sample_outproj(p, lds);
        pg8::Gemm g{(const bf16_t*)(p.ws + WS_YMIX), (const bf16_t*)(p.ws + WS_WOUT), 8192, DM, KO};
        pg8::StaticOrder S; S.init(8192, DM, (int)gridDim.x, (int)blockIdx.x);
        LAS float* tab = (LAS float*)(lds + pg8::STAGE_BYTES);
        { pg8::Unit u0; S.next(0, u0);
          if (threadIdx.x < 256) { const int r = u0.pm * 256 + threadIdx.x; const float s1 = ((const float*)(p.ws + WS_SSQ1))[r], s2 = ((const float*)(p.ws + WS_SSQ2))[r];
              const float q1 = s1 * (1.0f / 2048.f) + EPS, q2 = s2 * (1.0f / 2048.f) + EPS;
              tab[threadIdx.x] = __builtin_sqrtf(q2 / q1); tab[256 + threadIdx.x] = __builtin_amdgcn_rsqf(q2); }
          __syncthreads(); }
        pg8::EpiOut E{p.out + O_YP, tab};
        if (!(p.flags & 2)) pg8::gemm_phase<pg8::EpiOut>(lds, g, S, E);
    }
    SEAM(4);
    if (IN(5)) p4_final(p);
#undef IN
#undef SEAM
}

extern "C" void kernel_launch(void* const* d_in, const int* in_sizes, int n_in, void* d_out, int out_size, void* d_ws, size_t ws_size, hipStream_t stream) {
    static int grid = 0;
    if (grid == 0) {
        int dev = 0, cus = 0, per_cu = 0;
        hipGetDevice(&dev); hipDeviceGetAttribute(&cus, hipDeviceAttributeMultiprocessorCount, dev);
        hipFuncSetAttribute((const void*)hymba_fwd, hipFuncAttributeMaxDynamicSharedMemorySize, LDS_BYTES);
        hipOccupancyMaxActiveBlocksPerMultiprocessor(&per_cu, (const void*)hymba_fwd, 512, LDS_BYTES);
        if (per_cu < 1) per_cu = 1;
        grid = cus * 1;
        if (grid > 256) grid = 256;
        if (ws_size < WS_END) { fprintf(stderr, "workspace too small: %zu < %zu\n", ws_size, (size_t)WS_END); }
    }
    Params p{};
    p.x_prompt = (const float*)d_in[0]; p.x_sample = (const float*)d_in[1]; p.state_ssm = (const float*)d_in[2]; p.state_ssd_conv = (const float*)d_in[3];
    p.state_short_conv = (const float*)d_in[4]; p.meta = (const float*)d_in[5]; p.norm_w = (const float*)d_in[6]; p.w_in = (const float*)d_in[7];
    p.conv_ssd_w = (const float*)d_in[8]; p.conv_ssd_b = (const float*)d_in[9]; p.dt_bias = (const float*)d_in[10]; p.a_log = (const float*)d_in[11];
    p.d_skip = (const float*)d_in[12]; p.ssd_norm_w = (const float*)d_in[13]; p.conv_sc_w = (const float*)d_in[14]; p.sc_norm_w = (const float*)d_in[15];
    p.w_out = (const float*)d_in[16]; p.final_norm_w = (const float*)d_in[17];
    p.out = (float*)d_out; p.ws = (unsigned char*)d_ws;
#if N_LAUNCH == 1
    p.ph_lo = 0; p.ph_hi = 6;
    void* args[] = {&p};
    hipError_t e = hipLaunchCooperativeKernel((const void*)hymba_fwd, dim3(grid), dim3(512), args, LDS_BYTES, stream);
    if (e != hipSuccess) fprintf(stderr, "cooperative launch failed: %s (grid %d)\n", hipGetErrorString(e), grid);
#else
    const int sched[][3] = {SCHED};
    for (unsigned li = 0; li < sizeof(sched) / sizeof(sched[0]); ++li) {
        p.ph_lo = sched[li][0]; p.ph_hi = sched[li][1]; p.flags = sched[li][2];
        void* args[] = {&p};
        hipError_t e = hipLaunchCooperativeKernel((const void*)hymba_fwd, dim3(grid), dim3(512), args, LDS_BYTES, stream);
        if (e != hipSuccess) fprintf(stderr, "cooperative launch failed: %s (grid %d)\n", hipGetErrorString(e), grid);
    }
#endif
}
```

```cpp
#include <hip/hip_runtime.h>
#include <hip/hip_cooperative_groups.h>
#include <cstdio>
namespace cg = cooperative_groups;

#define LAS __attribute__((address_space(3)))
typedef unsigned short bf16_t;
typedef short bf16x8 __attribute__((ext_vector_type(8)));
typedef float f32x4 __attribute__((ext_vector_type(4)));
typedef float f32x16 __attribute__((ext_vector_type(16)));
typedef unsigned u32x4 __attribute__((ext_vector_type(4)));
typedef unsigned u32x2 __attribute__((ext_vector_type(2)));

#ifndef N_LAUNCH
#define N_LAUNCH 1
#endif
#define REP0 1
#define REP1 1
#define REP3 1
#define SCHED {0,6,0}

constexpr int DM = 2048;
constexpr int SEQ = 2048, NB = 4, NS = 128, NMETA = 16;
constexpr int NPROJ = 13344;
constexpr int NP = 13568;
constexpr int MP = 8448;
constexpr int BROWS = 2064;
constexpr int ROW_S0 = 8256;
constexpr int ROW_END = 8384;
constexpr int YROW_S0 = 8192;
constexpr int DXBC = 3072;
constexpr int CZ = 0, CX = 2048, CBm = 4096, CCm = 4608, CZS = 5120, CBS = 7168, CCS = 9216, CHS = 11264, CDT = 13312;
constexpr int KO = 4096;
constexpr float EPS = 1e-5f;

constexpr size_t O_YP = 0;
constexpr size_t O_YS = O_YP + (size_t)NB * SEQ * DM;
constexpr size_t O_SSMP = O_YS + (size_t)NS * DM;
constexpr size_t O_CSP = O_SSMP + (size_t)NB * 32 * 64 * 128;
constexpr size_t O_SCP = O_CSP + (size_t)NB * 3 * DXBC;
constexpr size_t O_SSMS = O_SCP + (size_t)NB * 2 * DM;
constexpr size_t O_CSS = O_SSMS + (size_t)NS * 32 * 64 * 128;
constexpr size_t O_SCS = O_CSS + (size_t)NS * 3 * DXBC;

constexpr size_t WS_WIN = 0;
constexpr size_t WS_WOUT = WS_WIN + (size_t)NP * DM * 2;
constexpr size_t WS_HN = WS_WOUT + (size_t)DM * KO * 2;
constexpr size_t WS_PROJ = WS_HN + (size_t)MP * DM * 2;
constexpr size_t WS_YMIX = WS_PROJ + (size_t)MP * NP * 2;
constexpr size_t WS_SSQ1 = WS_YMIX + (size_t)MP * KO * 2;
constexpr size_t WS_SSQ2 = WS_SSQ1 + (size_t)MP * 4;
constexpr size_t WS_SSQ3 = WS_SSQ2 + (size_t)MP * 4;
constexpr size_t WS_SSQ4 = WS_SSQ3 + (size_t)8192 * 32 * 4;
constexpr size_t WS_XC = WS_SSQ4 + (size_t)128 * 128 * 4;
constexpr size_t WS_DTV = WS_XC + (size_t)MP * DXBC * 2;
constexpr size_t WS_BAR = WS_DTV + (size_t)MP * 32 * 4;
constexpr size_t WS_END = WS_BAR + 16384;

constexpr int LDS_BYTES = 147456;

struct Params {
    const float* x_prompt; const float* x_sample; const float* state_ssm; const float* state_ssd_conv; const float* state_short_conv;
    const float* meta; const float* norm_w; const float* w_in; const float* conv_ssd_w; const float* conv_ssd_b; const float* dt_bias;
    const float* a_log; const float* d_skip; const float* ssd_norm_w; const float* conv_sc_w; const float* sc_norm_w; const float* w_out;
    const float* final_norm_w;
    float* out; unsigned char* ws;
    int ph_lo, ph_hi, flags, pad;
};

__device__ __forceinline__ unsigned cvt_pk_bf16(float lo, float hi) { unsigned r; asm("v_cvt_pk_bf16_f32 %0, %1, %2" : "=v"(r) : "v"(lo), "v"(hi)); return r; }
__device__ __forceinline__ float bf_lo(unsigned u) { return __uint_as_float(u << 16); }
__device__ __forceinline__ float bf_hi(unsigned u) { return __uint_as_float(u & 0xffff0000u); }
__device__ __forceinline__ float bf1(bf16_t u) { return __uint_as_float(((unsigned)u) << 16); }
__device__ __forceinline__ float silu_f(float x) { return x * __builtin_amdgcn_rcpf(1.0f + __expf(-x)); }
__device__ __forceinline__ float softplus_f(float x) { return x > 20.f ? x : log1pf(__expf(x)); }
template <int CTRL> __device__ __forceinline__ float dpp_f(float v) { return __int_as_float(__builtin_amdgcn_update_dpp(0, __float_as_int(v), CTRL, 0xF, 0xF, false)); }
__device__ __forceinline__ float sum8_dpp(float v) { v += dpp_f<0xB1>(v); v += dpp_f<0x4E>(v); v += dpp_f<0x141>(v); return v; }
__device__ __forceinline__ float wave_sum(float v) {
    v = sum8_dpp(v);
    v += __shfl_xor(v, 8); v += __shfl_xor(v, 16); v += __shfl_xor(v, 32);
    return v;
}
__device__ __forceinline__ void unpack8(const u32x4 u, float (&f)[8]) {
    f[0] = bf_lo(u.x); f[1] = bf_hi(u.x); f[2] = bf_lo(u.y); f[3] = bf_hi(u.y); f[4] = bf_lo(u.z); f[5] = bf_hi(u.z); f[6] = bf_lo(u.w); f[7] = bf_hi(u.w);
}

namespace pg8 {
constexpr int BM = 256, BK = 64, HALF = 128, HTB = HALF * BK * 2, STAGE_BYTES = 8 * HTB, NXCD = 8, WGM = 8;
__device__ __forceinline__ int lds_byte(int r, int c) { const int st = (r >> 4) * 2 + (c >> 5), rr = r & 15, cc = c & 31, ob = rr * 64 + cc * 2; return st * 1024 + (ob ^ (((ob >> 9) & 1) << 5)); }
__device__ __forceinline__ void stage_rc(int b, int& R, int& C) { const int st = b / 1024, sb = b % 1024, swz = sb ^ (((sb >> 9) & 1) << 5); R = (st >> 1) * 16 + swz / 64; C = (st & 1) * 32 + (swz % 64) / 2; }
__device__ __forceinline__ int perm32(int rho) { const int n = rho >> 4, i = rho & 15; return 8 * (i >> 2) + 4 * n + (i & 3); }
struct Unit { int pm, pn; };
struct Gemm { const bf16_t* A; const bf16_t* Bt; int M, N, K; };
struct StaticOrder {
    int nM, nN, nwg, G, c;
    __device__ void init(int M, int N, int G_, int c_) { nM = M / BM; nN = N / BM; nwg = nM * nN; G = G_; c = c_; }
    __device__ bool next(int i, Unit& u) const {
        const long L = (long)i * G + c; if (L >= nwg) return false;
        int wgid = (int)L; { const int q = nwg / NXCD, r = nwg % NXCD, xcd = wgid % NXCD, off = wgid / NXCD; wgid = (xcd < r ? xcd * (q + 1) : r * (q + 1) + (xcd - r) * q) + off; }
        const int nig = WGM * nN, gid = wgid / nig, fm = gid * WGM, gsz = (nM - fm) < WGM ? (nM - fm) : WGM;
        u.pm = fm + ((wgid % nig) % gsz); u.pn = (wgid % nig) / gsz; return true;
    }
};

struct EpiProj {
    static constexpr bool PERM = true, MID = false;
    bf16_t* O; int ldc;
    __device__ __forceinline__ void mid(f32x4 (&acc)[2][2][4][2], const Unit& u, int wr, int wc, int fr, int fq) const {}
    __device__ __forceinline__ void operator()(const f32x4 (&acc)[2][2][4][2], const Unit& u, int wr, int wc, int fr, int fq) const {
        const int row0 = u.pm * BM + wr * 64 + fr; const int col0 = u.pn * BM + wc * 32 + 8 * fq;
#pragma unroll
        for (int ai = 0; ai < 2; ++ai)
#pragma unroll
            for (int m = 0; m < 4; ++m) { bf16_t* rowp = O + (size_t)(row0 + ai * HALF + m * 16) * ldc + col0;
#pragma unroll
                for (int bj = 0; bj < 2; ++bj) { const f32x4 v0 = acc[ai][bj][m][0], v1 = acc[ai][bj][m][1];
                    u32x4 w; w.x = cvt_pk_bf16(v0[0], v0[1]); w.y = cvt_pk_bf16(v0[2], v0[3]); w.z = cvt_pk_bf16(v1[0], v1[1]); w.w = cvt_pk_bf16(v1[2], v1[3]);
                    *(u32x4*)(rowp + bj * HALF) = w; } }
    }
};
struct EpiOut {
    static constexpr bool PERM = false, MID = true;
    float* C; LAS const float* tab;
    __device__ __forceinline__ void mid(f32x4 (&acc)[2][2][4][2], const Unit& u, int wr, int wc, int fr, int fq) const {
#pragma unroll
        for (int ai = 0; ai < 2; ++ai)
#pragma unroll
            for (int m = 0; m < 4; ++m) { const float f = tab[wr * 64 + fr + ai * HALF + m * 16];
#pragma unroll
                for (int bj = 0; bj < 2; ++bj)
#pragma unroll
                    for (int n = 0; n < 2; ++n) acc[ai][bj][m][n] *= f; }
    }
    __device__ __forceinline__ void operator()(const f32x4 (&acc)[2][2][4][2], const Unit& u, int wr, int wc, int fr, int fq) const {
        const int row0 = u.pm * BM + wr * 64 + fr, col0 = u.pn * BM + wc * 32 + 4 * fq;
#pragma unroll
        for (int ai = 0; ai < 2; ++ai)
#pragma unroll
            for (int m = 0; m < 4; ++m) { const int r = row0 + ai * HALF + m * 16;
                const float rs = tab[256 + wr * 64 + fr + ai * HALF + m * 16];
                float* rowp = C + (size_t)r * DM + col0;
#pragma unroll
                for (int bj = 0; bj < 2; ++bj)
#pragma unroll
                    for (int n = 0; n < 2; ++n) *(f32x4*)(rowp + bj * HALF + n * 16) = acc[ai][bj][m][n] * rs; }
    }
};

template <class Epi>
__device__ __forceinline__ void gemm_phase(LAS unsigned char* lds, const Gemm g, const StaticOrder& S, const Epi& E) {
    const int tid = threadIdx.x, wid = __builtin_amdgcn_readfirstlane(tid >> 6), lane = tid & 63, wr = wid >> 2, wc = wid & 3, fr = lane & 15, fq = lane >> 4;
    const int K = g.K, nt = K / BK;
    unsigned voffA[2], voffB[2];
#pragma unroll
    for (int i = 0; i < 2; ++i) { int R, C; stage_rc(tid * 16 + i * 8192, R, C); const int Rb = Epi::PERM ? ((R & ~31) + perm32(R & 31)) : R;
        voffA[i] = (unsigned)(R * K + C) * 2u; voffB[i] = (unsigned)(Rb * K + C) * 2u; }
    const size_t kstep = (size_t)(BK * 2);
    const size_t hstep = (size_t)HALF * K * 2;
    const size_t tstep = 2 * hstep;
    const unsigned ldsw = (unsigned)wid * 1024u;
    const int aoff = lds_byte(wr * 64 + fr, fq * 8), boff = lds_byte(wc * 32 + fr, fq * 8);
#define PG8_SA(b, h) (((b) * 2 + (h)) * HTB)
#define PG8_SB(b, h) ((4 + (b) * 2 + (h)) * HTB)
#define PG8_STAGE(bufoff, gbase, voff) do { _Pragma("unroll") for (int _i = 0; _i < 2; ++_i) \
        __builtin_amdgcn_global_load_lds((const unsigned*)((const char*)(gbase) + (voff)[_i]), (LAS unsigned*)(lds + (bufoff) + ldsw + _i * 8192), 16, 0, 0); } while (0)
#define PG8_LDA(dst, b, h) do { _Pragma("unroll") for (int m = 0; m < 4; ++m) _Pragma("unroll") for (int k = 0; k < 2; ++k) dst[m][k] = *(const LAS bf16x8*)(lds + PG8_SA(b, h) + aoff + m * 2048 + k * 1024); } while (0)
#define PG8_LDB(dst, b, h) do { _Pragma("unroll") for (int n = 0; n < 2; ++n) _Pragma("unroll") for (int k = 0; k < 2; ++k) dst[n][k] = *(const LAS bf16x8*)(lds + PG8_SB(b, h) + boff + n * 2048 + k * 1024); } while (0)
#define PG8_MMA(ai, bj, At, Bt) do { __builtin_amdgcn_s_setprio(1); _Pragma("unroll") for (int m = 0; m < 4; ++m) _Pragma("unroll") for (int n = 0; n < 2; ++n) _Pragma("unroll") for (int k = 0; k < 2; ++k) \
        acc[ai][bj][m][n] = __builtin_amdgcn_mfma_f32_16x16x32_bf16(Bt[n][k], At[m][k], acc[ai][bj][m][n], 0, 0, 0); __builtin_amdgcn_s_setprio(0); } while (0)
#define PG8_WAIT_V(n) asm volatile("s_waitcnt vmcnt(" #n ")" ::: "memory")
#define PG8_WAIT_L(n) asm volatile("s_waitcnt lgkmcnt(" #n ")" ::: "memory")
#define PG8_BAR __builtin_amdgcn_s_barrier()
#define PG8_SCHED __builtin_amdgcn_sched_barrier(0)
    Unit cur, nxt; int ui = 0;
    if (!S.next(0, cur)) return;
    f32x4 acc[2][2][4][2];
#pragma unroll
    for (int a = 0; a < 2; ++a)
#pragma unroll
        for (int b = 0; b < 2; ++b)
#pragma unroll
            for (int m = 0; m < 4; ++m)
#pragma unroll
                for (int n = 0; n < 2; ++n) acc[a][b][m][n] = (f32x4){0.f, 0.f, 0.f, 0.f};
    bf16x8 At[4][2], B0[2][2], B1[2][2];
    const char* cA = (const char*)g.A + (size_t)cur.pm * tstep; const char* cB = (const char*)g.Bt + (size_t)cur.pn * tstep;
    PG8_STAGE(PG8_SB(0, 0), cB, voffB); PG8_STAGE(PG8_SA(0, 0), cA, voffA); PG8_STAGE(PG8_SB(0, 1), cB + hstep, voffB); PG8_STAGE(PG8_SA(0, 1), cA + hstep, voffA);
    if (wr == 1) PG8_BAR;
    PG8_WAIT_V(4); PG8_BAR;
    PG8_STAGE(PG8_SB(1, 0), cB + kstep, voffB); PG8_STAGE(PG8_SA(1, 0), cA + kstep, voffA); PG8_STAGE(PG8_SB(1, 1), cB + hstep + kstep, voffB);
    PG8_WAIT_V(6); PG8_BAR;
    for (;;) {
        const bool has_next = S.next(ui + 1, nxt);
        const char* nA = has_next ? (const char*)g.A + (size_t)nxt.pm * tstep : cA; const char* nB = has_next ? (const char*)g.Bt + (size_t)nxt.pn * tstep : cB;
        for (int t = 0; t < nt; t += 2) {
            const bool last = (t == nt - 2);
            const char* a1 = cA + (size_t)(t + 1) * kstep;
            const char* a2 = last ? nA : cA + (size_t)(t + 2) * kstep; const char* b2 = last ? nB : cB + (size_t)(t + 2) * kstep;
            const char* a3 = a2 + kstep; const char* b3 = b2 + kstep;
            if constexpr (Epi::MID) { if (t == (nt >> 1)) E.mid(acc, cur, wr, wc, fr, fq); }
            PG8_LDB(B0, 0, 0); PG8_SCHED; PG8_LDA(At, 0, 0); PG8_STAGE(PG8_SA(1, 1), a1 + hstep, voffA);
            PG8_WAIT_L(8); PG8_BAR; PG8_WAIT_L(0); PG8_MMA(0, 0, At, B0); PG8_BAR; PG8_SCHED;
            PG8_LDB(B1, 0, 1); PG8_STAGE(PG8_SB(0, 0), b2, voffB);
            PG8_BAR; PG8_WAIT_L(0); PG8_MMA(0, 1, At, B1); PG8_BAR;
            PG8_LDA(At, 0, 1); PG8_STAGE(PG8_SA(0, 0), a2, voffA);
            PG8_BAR; PG8_WAIT_L(0); PG8_MMA(1, 0, At, B0); PG8_BAR; PG8_SCHED;
            PG8_STAGE(PG8_SB(0, 1), b2 + hstep, voffB);
            PG8_WAIT_V(6); PG8_BAR; PG8_MMA(1, 1, At, B1); PG8_BAR;
            PG8_LDB(B0, 1, 0); PG8_SCHED; PG8_LDA(At, 1, 0); PG8_STAGE(PG8_SA(0, 1), a2 + hstep, voffA);
            PG8_WAIT_L(8); PG8_BAR; PG8_WAIT_L(0); PG8_MMA(0, 0, At, B0); PG8_BAR; PG8_SCHED;
            PG8_LDB(B1, 1, 1); PG8_STAGE(PG8_SB(1, 0), b3, voffB);
            PG8_BAR; PG8_WAIT_L(0); PG8_MMA(0, 1, At, B1); PG8_BAR;
            PG8_LDA(At, 1, 1); PG8_STAGE(PG8_SA(1, 0), a3, voffA);
            PG8_BAR; PG8_WAIT_L(0); PG8_MMA(1, 0, At, B0); PG8_BAR; PG8_SCHED;
            PG8_STAGE(PG8_SB(1, 1), b3 + hstep, voffB);
            PG8_WAIT_V(6); PG8_BAR; PG8_MMA(1, 1, At, B1); PG8_BAR;
        }
        E(acc, cur, wr, wc, fr, fq);
        if (!has_next) break;
#pragma unroll
        for (int a = 0; a < 2; ++a)
#pragma unroll
            for (int b = 0; b < 2; ++b)
#pragma unroll
                for (int m = 0; m < 4; ++m)
#pragma unroll
                    for (int n = 0; n < 2; ++n) acc[a][b][m][n] = (f32x4){0.f, 0.f, 0.f, 0.f};
        cur = nxt; cA = nA; cB = nB; ++ui;
    }
    PG8_WAIT_V(0);
    if (wr == 0) PG8_BAR;
    PG8_BAR;
#undef PG8_SA
#undef PG8_SB
#undef PG8_STAGE
#undef PG8_LDA
#undef PG8_LDB
#undef PG8_MMA
#undef PG8_WAIT_V
#undef PG8_WAIT_L
#undef PG8_BAR
#undef PG8_SCHED
}
}

struct TrTile { const float* src; int spitch, scol0, nvalid, k0; bf16_t* dst; int dpitch, n0; const float* sc0; const float* sc1; };
__device__ __forceinline__ TrTile tr_desc(const Params& p, int t) {
    constexpr int T_IN = 212 * 16;
    TrTile d;
    if (t < T_IN) {
        const int nt_ = t >> 4, kt = t & 15; const int n0 = nt_ * 64;
        int scol, nvalid;
        if (n0 < 5120) { scol = n0; nvalid = 64; }
        else if (n0 < 13312) { scol = n0 + 32; nvalid = 64; }
        else if (n0 == 13312) { scol = 5120; nvalid = 32; }
        else { scol = 0; nvalid = 0; }
        d.src = p.w_in; d.spitch = NPROJ; d.scol0 = scol; d.nvalid = nvalid; d.k0 = kt * 128; d.dst = (bf16_t*)(p.ws + WS_WIN); d.dpitch = DM; d.n0 = n0; d.sc0 = nullptr; d.sc1 = nullptr;
    } else {
        const int tt = t - T_IN; const int nt_ = tt >> 5, kt = tt & 31;
        d.src = p.w_out; d.spitch = DM; d.scol0 = nt_ * 64; d.nvalid = 64; d.k0 = kt * 128; d.dst = (bf16_t*)(p.ws + WS_WOUT); d.dpitch = KO; d.n0 = nt_ * 64; d.sc0 = p.ssd_norm_w; d.sc1 = p.sc_norm_w;
    }
    return d;
}
__device__ __forceinline__ void tr_load(const TrTile& d, f32x4 (&r)[2][2], float (&sc)[2][2]) {
    const int tid = threadIdx.x, nq = tid & 15, kp = tid >> 4;
#pragma unroll
    for (int pass = 0; pass < 2; ++pass) {
        const int kg = d.k0 + pass * 64 + kp * 2;
        r[pass][0] = (f32x4){0.f, 0.f, 0.f, 0.f}; r[pass][1] = r[pass][0];
        if (nq * 4 < d.nvalid) {
            r[pass][0] = __builtin_nontemporal_load((const f32x4*)(d.src + (size_t)kg * d.spitch + d.scol0 + nq * 4));
            r[pass][1] = __builtin_nontemporal_load((const f32x4*)(d.src + (size_t)(kg + 1) * d.spitch + d.scol0 + nq * 4));
        }
        sc[pass][0] = 1.f; sc[pass][1] = 1.f;
        if (d.sc0) { sc[pass][0] = (kg < 2048) ? d.sc0[kg] : d.sc1[kg - 2048]; sc[pass][1] = (kg + 1 < 2048) ? d.sc0[kg + 1] : d.sc1[kg + 1 - 2048]; }
    }
}
__device__ __forceinline__ void tr_store(LAS unsigned char* lds, const TrTile& d, const f32x4 (&r)[2][2], const float (&sc)[2][2]) {
    const int tid = threadIdx.x, nq = tid & 15, kp = tid >> 4;
    LAS unsigned* T = (LAS unsigned*)lds;
#pragma unroll
    for (int pass = 0; pass < 2; ++pass)
#pragma unroll
        for (int j = 0; j < 4; ++j) T[(nq * 4 + j) * 68 + pass * 32 + kp] = cvt_pk_bf16(r[pass][0][j] * sc[pass][0], r[pass][1][j] * sc[pass][1]);
    __syncthreads();
#pragma unroll
    for (int i = 0; i < 2; ++i) {
        const int ch = tid + i * 512; const int n = ch >> 4, c16 = ch & 15;
        const u32x4 v = *(const LAS u32x4*)(T + n * 68 + c16 * 4);
        *(u32x4*)(d.dst + (size_t)(d.n0 + n) * d.dpitch + d.k0 + c16 * 8) = v;
    }
    __syncthreads();
}

__device__ void p0_prep(const Params& p, LAS unsigned char* lds) {
    const int tid = threadIdx.x, lane = tid & 63, wid = tid >> 6;
    bf16_t* hn = (bf16_t*)(p.ws + WS_HN);
    { float* s1 = (float*)(p.ws + WS_SSQ1); for (int i = blockIdx.x * 512 + tid; i < 2 * MP; i += gridDim.x * 512) s1[i] = 0.f; }
    constexpr int T_ALL = 212 * 16 + 32 * 32;
    {
        int t = blockIdx.x;
        TrTile dc = tr_desc(p, t < T_ALL ? t : 0);
        f32x4 rc[2][2]; float sc[2][2];
        if (t < T_ALL) tr_load(dc, rc, sc);
        while (t < T_ALL) {
            const int tn = t + gridDim.x;
            TrTile dn = tr_desc(p, tn < T_ALL ? tn : 0);
            f32x4 rn[2][2]; float sn[2][2];
            if (tn < T_ALL) tr_load(dn, rn, sn);
            tr_store(lds, dc, rc, sc);
            dc = dn; t = tn;
#pragma unroll
            for (int a = 0; a < 2; ++a)
#pragma unroll
                for (int b = 0; b < 2; ++b) { rc[a][b] = rn[a][b]; sc[a][b] = sn[a][b]; }
        }
    }
    const int gw = blockIdx.x * 8 + wid, nw = gridDim.x * 8;
    for (int r = gw; r < MP; r += nw) {
        bf16_t* o = hn + (size_t)r * DM;
        if (r >= ROW_END) {
#pragma unroll
            for (int i = 0; i < 8; ++i) *(u32x2*)(o + i * 256 + lane * 4) = (u32x2){0u, 0u};
            continue;
        }
        const float* src;
        if (r < ROW_S0) { const int bb = r / BROWS, q = r - bb * BROWS; src = q < NMETA ? p.meta + (size_t)q * DM : p.x_prompt + ((size_t)bb * SEQ + (q - NMETA)) * DM; }
        else src = p.x_sample + (size_t)(r - ROW_S0) * DM;
        f32x4 v[8]; float ss = 0.f;
#pragma unroll
        for (int i = 0; i < 8; ++i) { v[i] = *(const f32x4*)(src + i * 256 + lane * 4); ss += (v[i][0] * v[i][0] + v[i][1] * v[i][1]) + (v[i][2] * v[i][2] + v[i][3] * v[i][3]); }
        ss = wave_sum(ss);
        const float rs = __builtin_amdgcn_rsqf(ss * (1.0f / 2048.f) + EPS);
#pragma unroll
        for (int i = 0; i < 8; ++i) { const f32x4 w = *(const f32x4*)(p.norm_w + i * 256 + lane * 4);
            u32x2 pk; pk.x = cvt_pk_bf16(v[i][0] * rs * w[0], v[i][1] * rs * w[1]); pk.y = cvt_pk_bf16(v[i][2] * rs * w[2], v[i][3] * rs * w[3]);
            *(u32x2*)(o + i * 256 + lane * 4) = pk; }
    }
}

constexpr int PIT = 272;
constexpr int L_CS = 0, L_BS = 34816, L_BT = 69632, L_XT = 104448, L_SB = 121856, L_SC = 139264;
constexpr int F_DT = 0, F_ACS = 256, F_WV = 512, F_SSL = 768, F_AEND = 1024;

__device__ __forceinline__ void scan_load(const Params& p, int rb, int lmin, int h, float& d0, float& d1) {
    const int lane = threadIdx.x & 63; const float* dtv = (const float*)(p.ws + WS_DTV);
    const int l0 = 2 * lane, g0 = max(rb + l0, 0), g1 = max(rb + l0 + 1, 0);
    d0 = dtv[g0 * 32 + h]; d1 = dtv[g1 * 32 + h];
    d0 = l0 >= lmin ? d0 : 0.f; d1 = l0 + 1 >= lmin ? d1 : 0.f;
}
__device__ __forceinline__ void scan_finish(LAS float* sm, int buf, float d0, float d1, float a_neg) {
    const int lane = threadIdx.x & 63;
    const float x0 = d0 * a_neg, x1 = d1 * a_neg;
    float s = x0 + x1;
#pragma unroll
    for (int o = 1; o < 64; o <<= 1) { const float t = __shfl_up(s, o); if (lane >= o) s += t; }
    const float c1 = s, c0 = s - x1;
    const float aend = __shfl(s, 63);
    sm[F_DT + buf * 128 + 2 * lane] = d0; sm[F_DT + buf * 128 + 2 * lane + 1] = d1;
    sm[F_ACS + buf * 128 + 2 * lane] = c0; sm[F_ACS + buf * 128 + 2 * lane + 1] = c1;
    sm[F_WV + buf * 128 + 2 * lane] = d0 * __expf(aend - c0); sm[F_WV + buf * 128 + 2 * lane + 1] = d1 * __expf(aend - c1);
    if (lane == 0) sm[F_AEND + buf] = aend;
}

template <int NR, class Store>
__device__ __forceinline__ void conv_rows(const Params& p, int rb, int lmin, int l0, int pcol, int wcol, Store&& st) {
    const bf16_t* proj = (const bf16_t*)(p.ws + WS_PROJ);
    u32x4 raw[NR + 3];
#pragma unroll
    for (int i = 0; i < NR + 3; ++i) { const int l = l0 - 3 + i; const int g = max(rb + l, 0);
        raw[i] = *(const u32x4*)(proj + (size_t)g * NP + pcol);
        if (l < lmin) raw[i] = (u32x4){0u, 0u, 0u, 0u}; }
    float w[4][8], bias[8];
#pragma unroll
    for (int k = 0; k < 4; ++k) { const f32x4 a = *(const f32x4*)(p.conv_ssd_w + k * DXBC + wcol), b = *(const f32x4*)(p.conv_ssd_w + k * DXBC + wcol + 4);
        w[k][0] = a[0]; w[k][1] = a[1]; w[k][2] = a[2]; w[k][3] = a[3]; w[k][4] = b[0]; w[k][5] = b[1]; w[k][6] = b[2]; w[k][7] = b[3]; }
    { const f32x4 a = *(const f32x4*)(p.conv_ssd_b + wcol), b = *(const f32x4*)(p.conv_ssd_b + wcol + 4);
      bias[0] = a[0]; bias[1] = a[1]; bias[2] = a[2]; bias[3] = a[3]; bias[4] = b[0]; bias[5] = b[1]; bias[6] = b[2]; bias[7] = b[3]; }
    float h0[8], h1[8], h2[8], cur[8];
    unpack8(raw[0], h0); unpack8(raw[1], h1); unpack8(raw[2], h2);
#pragma unroll
    for (int i = 0; i < NR; ++i) {
        unpack8(raw[i + 3], cur);
        float o[8];
#pragma unroll
        for (int j = 0; j < 8; ++j) { const float a = bias[j] + w[0][j] * h0[j] + w[1][j] * h1[j] + w[2][j] * h2[j] + w[3][j] * cur[j]; o[j] = silu_f(a); }
        st(i, o);
#pragma unroll
        for (int j = 0; j < 8; ++j) { h0[j] = h1[j]; h1[j] = h2[j]; h2[j] = cur[j]; }
    }
}

__device__ void conv_pre(const Params& p) {
    const bf16_t* proj = (const bf16_t*)(p.ws + WS_PROJ);
    bf16_t* xc = (bf16_t*)(p.ws + WS_XC); float* dtv = (float*)(p.ws + WS_DTV);
    const int gt = blockIdx.x * 512 + threadIdx.x, nthr = gridDim.x * 512;
    for (int T = gt; T < (ROW_S0 / 4) * 384; T += nthr) {
        const int cgp = T % 384, rg = T / 384; const int R0 = rg * 4, col = cgp * 8;
        const int lmin = (R0 % BROWS) != 0 ? -3 : 0;
        conv_rows<4>(p, R0, lmin, 0, CX + col, col, [&](int i, const float (&o)[8]) {
            u32x4 pk; pk.x = cvt_pk_bf16(o[0], o[1]); pk.y = cvt_pk_bf16(o[2], o[3]); pk.z = cvt_pk_bf16(o[4], o[5]); pk.w = cvt_pk_bf16(o[6], o[7]);
            *(u32x4*)(xc + (size_t)(R0 + i) * DXBC + col) = pk; });
    }
    for (int T = gt; T < ROW_S0 * 32; T += nthr) { const int R = T >> 5, h = T & 31; dtv[T] = softplus_f(bf1(proj[(size_t)R * NP + CDT + h]) + p.dt_bias[h]); }
}

__device__ __forceinline__ int swz(int row, int l) { return row * PIT + ((((l >> 3) ^ (row >> 3)) & 15) << 4) + ((l & 7) << 1); }

__device__ void ssd_item(const Params& p, LAS unsigned char* lds, int item) {
    const int tid = threadIdx.x, lane = tid & 63, w = __builtin_amdgcn_readfirstlane(tid >> 6), r = lane & 31, hh = lane >> 5;
    const int pair = (item & 7) + 8 * (item >> 6), hg = (item >> 3) & 7;
    const int b = pair >> 2, g = pair & 3, h = g * 8 + hg;
    const bf16_t* proj = (const bf16_t*)(p.ws + WS_PROJ);
    const bf16_t* xc = (const bf16_t*)(p.ws + WS_XC);
    bf16_t* ymix = (bf16_t*)(p.ws + WS_YMIX);
    float* ssq1 = (float*)(p.ws + WS_SSQ1);
    LAS float* sm = (LAS float*)(lds + L_SC);
    const float a_neg = -__expf(p.a_log[h]), Dh = p.d_skip[h];
    const int l0 = (((tid >> 2) & 3) | ((tid >> 6) << 2)) * 4, n0 = ((tid & 3) | (((tid >> 4) & 3) << 2)) * 8; const int xl0 = (tid >> 3) * 2, p0 = (tid & 7) * 8;
    const int colB = 2048 + g * 128 + n0, colC = colB + 512, colX = h * 64 + p0;
    u32x4 pB[4], pC[4], pX[2];
#define SSD_PREFETCH(RB) do { \
        _Pragma("unroll") for (int i = 0; i < 4; ++i) { const size_t gg = (size_t)max((RB) + l0 + i, 0) * DXBC; pB[i] = *(const u32x4*)(xc + gg + colB); pC[i] = *(const u32x4*)(xc + gg + colC); } \
        _Pragma("unroll") for (int i = 0; i < 2; ++i) { const size_t gg = (size_t)max((RB) + xl0 + i, 0) * DXBC; pX[i] = *(const u32x4*)(xc + gg + colX); } } while (0)
    SSD_PREFETCH(b * BROWS - 112);
    for (int i = tid; i < 17408 / 4; i += 512) ((LAS unsigned*)(lds + L_SB))[i] = 0u;
    if (w == 1) { float d0, d1; scan_load(p, b * BROWS - 112, 112, h, d0, d1); scan_finish(sm, 0, d0, d1, a_neg); }
    f32x16 accS;
#pragma unroll
    for (int i = 0; i < 16; ++i) accS[i] = 0.f;
    const int lt = w < 4 ? (w >> 1) : 3 - ((w - 4) >> 1), pt = w & 1, pt2 = w >> 2, nt = w & 3;
    __syncthreads();
    for (int c = 0; c <= 16; ++c) {
        const int buf = c & 1; const int rb = b * BROWS + NMETA + (c - 1) * 128, lmin = (c == 0) ? 112 : -3; const int base = b * SEQ + (c - 1) * 128;
        {
            unsigned bt[8][2], xt[8];
#pragma unroll
            for (int i = 0; i < 4; ++i) {
                const bool valid = (l0 + i) >= lmin;
                const u32x4 vb = valid ? pB[i] : (u32x4){0u, 0u, 0u, 0u}, vc = valid ? pC[i] : (u32x4){0u, 0u, 0u, 0u};
                *(LAS u32x4*)(lds + L_BS + (l0 + i) * PIT + n0 * 2) = vb;
                *(LAS u32x4*)(lds + L_CS + (l0 + i) * PIT + n0 * 2) = vc;
                float f[8]; unpack8(vb, f);
                const float wl = sm[F_WV + buf * 128 + l0 + i];
#pragma unroll
                for (int j = 0; j < 8; ++j) { const unsigned q = cvt_pk_bf16(f[j] * wl, 0.f);
                    if (i & 1) bt[j][i >> 1] |= q << 16; else bt[j][i >> 1] = q & 0xffffu; }
            }
#pragma unroll
            for (int j = 0; j < 8; ++j) *(LAS u32x2*)(lds + L_BT + swz(n0 + j, l0)) = (u32x2){bt[j][0], bt[j][1]};
#pragma unroll
            for (int i = 0; i < 2; ++i) {
                const bool valid = (xl0 + i) >= lmin;
                const u32x4 vx = valid ? pX[i] : (u32x4){0u, 0u, 0u, 0u};
                const unsigned ws4[4] = {vx.x, vx.y, vx.z, vx.w};
#pragma unroll
                for (int j = 0; j < 8; ++j) { const unsigned q = (j & 1) ? (ws4[j >> 1] >> 16) : (ws4[j >> 1] & 0xffffu);
                    if (i & 1) xt[j] |= q << 16; else xt[j] = q; }
            }
#pragma unroll
            for (int j = 0; j < 8; ++j) *(LAS unsigned*)(lds + L_XT + (p0 + j) * PIT + xl0 * 2) = xt[j];
        }
        u32x2 zr[4];
        if (c > 0) {
#pragma unroll
            for (int k = 0; k < 4; ++k) zr[k] = *(const u32x2*)(proj + (size_t)(rb + lt * 32 + r) * NP + CZ + h * 64 + pt * 32 + 8 * k + 4 * hh);
        }
        float sd0 = 0.f, sd1 = 0.f;
        if (w == 1 && c < 16) scan_load(p, rb + 128, -3, h, sd0, sd1);
        if (c < 16) SSD_PREFETCH(rb + 128);
        __syncthreads();
        f32x16 aD, aO;
#pragma unroll
        for (int i = 0; i < 16; ++i) { aD[i] = 0.f; aO[i] = 0.f; }
        if (c > 0) {
            const int lrow = lt * 32 + r; const float acl = sm[F_ACS + buf * 128 + lrow];
            for (int st = 0; st <= lt; ++st) {
                f32x16 cb;
#pragma unroll
                for (int i = 0; i < 16; ++i) cb[i] = 0.f;
#pragma unroll
                for (int ks = 0; ks < 8; ++ks) {
                    const bf16x8 a = *(const LAS bf16x8*)(lds + L_BS + (st * 32 + r) * PIT + (ks * 16 + hh * 8) * 2);
                    const bf16x8 bc = *(const LAS bf16x8*)(lds + L_CS + lrow * PIT + (ks * 16 + hh * 8) * 2);
                    cb = __builtin_amdgcn_mfma_f32_32x32x16_bf16(a, bc, cb, 0, 0, 0);
                }
                float mv[16];
#pragma unroll
                for (int g4 = 0; g4 < 4; ++g4) {
                    const int sb = st * 32 + 8 * g4 + 4 * hh;
                    const f32x4 as = *(const LAS f32x4*)(sm + F_ACS + buf * 128 + sb), dd = *(const LAS f32x4*)(sm + F_DT + buf * 128 + sb);
#pragma unroll
                    for (int j = 0; j < 4; ++j) mv[4 * g4 + j] = (sb + j <= lrow) ? cb[4 * g4 + j] * __expf(acl - as[j]) * dd[j] : 0.f;
                }
#pragma unroll
                for (int sp = 0; sp < 2; ++sp) {
                    u32x4 bp; bp.x = cvt_pk_bf16(mv[8 * sp + 0], mv[8 * sp + 1]); bp.y = cvt_pk_bf16(mv[8 * sp + 2], mv[8 * sp + 3]);
                    bp.z = cvt_pk_bf16(mv[8 * sp + 4], mv[8 * sp + 5]); bp.w = cvt_pk_bf16(mv[8 * sp + 6], mv[8 * sp + 7]);
                    const u32x2 xlo = *(const LAS u32x2*)(lds + L_XT + (pt * 32 + r) * PIT + (st * 32 + 16 * sp + 4 * hh) * 2);
                    const u32x2 xhi = *(const LAS u32x2*)(lds + L_XT + (pt * 32 + r) * PIT + (st * 32 + 16 * sp + 8 + 4 * hh) * 2);
                    const u32x4 ap = (u32x4){xlo.x, xlo.y, xhi.x, xhi.y};
                    aD = __builtin_amdgcn_mfma_f32_32x32x16_bf16(__builtin_bit_cast(bf16x8, ap), __builtin_bit_cast(bf16x8, bp), aD, 0, 0, 0);
                }
            }
#pragma unroll
            for (int ks = 0; ks < 8; ++ks) {
                const bf16x8 a = *(const LAS bf16x8*)(lds + L_CS + lrow * PIT + (ks * 16 + hh * 8) * 2);
                const bf16x8 bs = *(const LAS bf16x8*)(lds + L_SB + (pt * 32 + r) * PIT + (ks * 16 + hh * 8) * 2);
                aO = __builtin_amdgcn_mfma_f32_32x32x16_bf16(bs, a, aO, 0, 0, 0);
            }
        }
        {
            const float dec = __expf(sm[F_AEND + buf]);
#pragma unroll
            for (int i = 0; i < 16; ++i) accS[i] *= dec;
#pragma unroll
            for (int ks = 0; ks < 8; ++ks) {
                const bf16x8 a = *(const LAS bf16x8*)(lds + L_XT + (pt2 * 32 + r) * PIT + (ks * 16 + hh * 8) * 2);
                const bf16x8 bb = *(const LAS bf16x8*)(lds + L_BT + swz(nt * 32 + r, ks * 16 + hh * 8));
                accS = __builtin_amdgcn_mfma_f32_32x32x16_bf16(a, bb, accS, 0, 0, 0);
            }
        }
        if (w == 1 && c < 16) scan_finish(sm, buf ^ 1, sd0, sd1, a_neg);
        if (c > 0) {
            const int l = lt * 32 + r; const float eacs = __expf(sm[F_ACS + buf * 128 + l]);
            float q = 0.f;
#pragma unroll
            for (int k = 0; k < 4; ++k) {
                const int pl = pt * 32 + 8 * k + 4 * hh;
                const float z4[4] = {bf_lo(zr[k].x), bf_hi(zr[k].x), bf_lo(zr[k].y), bf_hi(zr[k].y)};
                float gv[4];
#pragma unroll
                for (int j = 0; j < 4; ++j) { const int i = 4 * k + j;
                    const float xv = bf1(*(const LAS bf16_t*)(lds + L_XT + (pl + j) * PIT + l * 2));
                    const float y = aD[i] + eacs * aO[i] + Dh * xv;
                    gv[j] = y * silu_f(z4[j]); q += gv[j] * gv[j]; }
                u32x2 pk; pk.x = cvt_pk_bf16(gv[0], gv[1]); pk.y = cvt_pk_bf16(gv[2], gv[3]);
                *(u32x2*)(ymix + (size_t)(base + l) * KO + h * 64 + pl) = pk;
            }
            q += __shfl_xor(q, 32);
            if (hh == 0) sm[F_SSL + pt * 128 + l] = q;
        }
        __syncthreads();
        if (c > 0 && tid < 128) unsafeAtomicAdd(ssq1 + base + tid, sm[F_SSL + tid] + sm[F_SSL + 128 + tid]);
#pragma unroll
        for (int i = 0; i < 16; ++i) { const int pp = pt2 * 32 + (i & 3) + 8 * (i >> 2) + 4 * hh;
            *(LAS bf16_t*)(lds + L_SB + pp * PIT + (nt * 32 + r) * 2) = (bf16_t)(cvt_pk_bf16(accS[i], 0.f) & 0xffffu); }
    }
#undef SSD_PREFETCH
    float* so = p.out + O_SSMP + ((size_t)(b * 32 + h) * 64) * 128;
#pragma unroll
    for (int i = 0; i < 16; ++i) { const int pp = pt2 * 32 + (i & 3) + 8 * (i >> 2) + 4 * hh; so[(size_t)pp * 128 + nt * 32 + r] = accS[i]; }
    __syncthreads();
}

__device__ __forceinline__ float block_sum(float v, LAS float* red) {
    v = wave_sum(v);
    __syncthreads();
    if ((threadIdx.x & 63) == 0) red[threadIdx.x >> 6] = v;
    __syncthreads();
    float s = 0.f;
#pragma unroll
    for (int i = 0; i < 8; ++i) s += red[i];
    return s;
}

__device__ void decode_item(const Params& p, LAS unsigned char* lds, int j) {
    const int tid = threadIdx.x, lane = tid & 63, w = tid >> 6;
    const bf16_t* proj = (const bf16_t*)(p.ws + WS_PROJ);
    bf16_t* ymix = (bf16_t*)(p.ws + WS_YMIX);
    const int R = YROW_S0 + j;
    const bf16_t* prow = proj + (size_t)(ROW_S0 + j) * NP;
    LAS float* xc = (LAS float*)lds;
    LAS float* yv = xc + 3072;
    LAS float* dts = yv + 2048;
    LAS float* dAs = dts + 32;
    LAS float* red = dAs + 32;
    {
        const float* cs = p.state_ssd_conv + (size_t)j * 3 * DXBC; float* co = p.out + O_CSS + (size_t)j * 3 * DXBC;
#pragma unroll
        for (int k = 0; k < 6; ++k) { const int col = tid + 512 * k;
            const float raw = bf1(prow[CX + col]); const float s0 = cs[col], s1 = cs[DXBC + col], s2 = cs[2 * DXBC + col];
            const float a = p.conv_ssd_b[col] + p.conv_ssd_w[col] * s0 + p.conv_ssd_w[DXBC + col] * s1 + p.conv_ssd_w[2 * DXBC + col] * s2 + p.conv_ssd_w[3 * DXBC + col] * raw;
            xc[col] = silu_f(a);
            co[col] = s1; co[DXBC + col] = s2; co[2 * DXBC + col] = raw; }
        if (tid < 32) { const float d = softplus_f(bf1(prow[CDT + tid]) + p.dt_bias[tid]); dts[tid] = d; dAs[tid] = __expf(d * (-__expf(p.a_log[tid]))); }
    }
    __syncthreads();
    {
        const int g = w >> 1, q = lane & 31, half = lane >> 5;
        const f32x4 Bq = *(const LAS f32x4*)(xc + 2048 + g * 128 + 4 * q), Cq = *(const LAS f32x4*)(xc + 2560 + g * 128 + 4 * q);
        const float* sin = p.state_ssm + (size_t)j * 32 * 64 * 128; float* sout = p.out + O_SSMS + (size_t)j * 32 * 64 * 128;
        const int b4 = (lane >> 4) & 1, b3 = (lane >> 3) & 1;
#define DEC_LOAD(buf, bi) do { const int h_ = 4 * w + ((bi) >> 1), it0_ = ((bi) & 1) * 16; \
            _Pragma("unroll") for (int u = 0; u < 16; ++u) buf[u] = __builtin_nontemporal_load((const f32x4*)(sin + ((size_t)h_ * 64 + 2 * (it0_ + u) + half) * 128 + 4 * q)); } while (0)
#define DEC_PROC(buf, bi) do { const int h_ = 4 * w + ((bi) >> 1), it0_ = ((bi) & 1) * 16; const float dtv = dts[h_], dA = dAs[h_], Dh = p.d_skip[h_]; \
            float yp[16]; \
            _Pragma("unroll") for (int u = 0; u < 16; ++u) { const int pp = 2 * (it0_ + u) + half; const float xd = xc[h_ * 64 + pp] * dtv; \
                const f32x4 sn = buf[u] * dA + Bq * xd; \
                __builtin_nontemporal_store(sn, (f32x4*)(sout + ((size_t)h_ * 64 + pp) * 128 + 4 * q)); \
                yp[u] = (sn[0] * Cq[0] + sn[1] * Cq[1]) + (sn[2] * Cq[2] + sn[3] * Cq[3]); } \
            float a8[8], a4[4]; \
            _Pragma("unroll") for (int k = 0; k < 8; ++k) { const float snd = b4 ? yp[k] : yp[8 + k], kp = b4 ? yp[8 + k] : yp[k]; a8[k] = kp + __shfl_xor(snd, 16); } \
            _Pragma("unroll") for (int k = 0; k < 4; ++k) { const float snd = b3 ? a8[k] : a8[4 + k], kp = b3 ? a8[4 + k] : a8[k]; a4[k] = sum8_dpp(kp + __shfl_xor(snd, 8)); } \
            if ((lane & 7) == 0) { _Pragma("unroll") for (int k = 0; k < 4; ++k) { const int pp = 2 * (it0_ + 8 * b4 + 4 * b3 + k) + half; yv[h_ * 64 + pp] = a4[k] + Dh * xc[h_ * 64 + pp]; } } } while (0)
        f32x4 bufA[16], bufB[16];
        DEC_LOAD(bufA, 0);
        for (int bi = 0; bi < 8; bi += 2) {
            DEC_LOAD(bufB, bi + 1);
            DEC_PROC(bufA, bi);
            if (bi + 2 < 8) DEC_LOAD(bufA, bi + 2);
            DEC_PROC(bufB, bi + 1);
        }
#undef DEC_LOAD
#undef DEC_PROC
    }
    __syncthreads();
    {
        const int c0 = tid * 4; const u32x2 zz = *(const u32x2*)(prow + CZ + c0);
        const float z[4] = {bf_lo(zz.x), bf_hi(zz.x), bf_lo(zz.y), bf_hi(zz.y)};
        float gv[4]; float ss = 0.f;
#pragma unroll
        for (int k = 0; k < 4; ++k) { gv[k] = yv[c0 + k] * silu_f(z[k]); ss += gv[k] * gv[k]; }
        const float tot = block_sum(ss, red); const float rs = __builtin_amdgcn_rsqf(tot * (1.0f / 2048.f) + EPS);
        u32x2 pk; pk.x = cvt_pk_bf16(gv[0] * rs, gv[1] * rs); pk.y = cvt_pk_bf16(gv[2] * rs, gv[3] * rs);
        *(u32x2*)(ymix + (size_t)R * KO + c0) = pk;
    }
    {
        const int c0 = tid * 4;
        const u32x2 zz = *(const u32x2*)(prow + CZS + c0), bb = *(const u32x2*)(prow + CBS + c0), cc = *(const u32x2*)(prow + CCS + c0), hh4 = *(const u32x2*)(prow + CHS + c0);
        const float z[4] = {bf_lo(zz.x), bf_hi(zz.x), bf_lo(zz.y), bf_hi(zz.y)}, bv[4] = {bf_lo(bb.x), bf_hi(bb.x), bf_lo(bb.y), bf_hi(bb.y)};
        const float cv[4] = {bf_lo(cc.x), bf_hi(cc.x), bf_lo(cc.y), bf_hi(cc.y)}, hv[4] = {bf_lo(hh4.x), bf_hi(hh4.x), bf_lo(hh4.y), bf_hi(hh4.y)};
        const float* ss_in = p.state_short_conv + (size_t)j * 2 * DM; float* so = p.out + O_SCS + (size_t)j * 2 * DM;
        const f32x4 s0 = *(const f32x4*)(ss_in + c0), s1 = *(const f32x4*)(ss_in + DM + c0);
        const f32x4 w0 = *(const f32x4*)(p.conv_sc_w + c0), w1 = *(const f32x4*)(p.conv_sc_w + DM + c0), w2 = *(const f32x4*)(p.conv_sc_w + 2 * DM + c0);
        float y[4]; f32x4 vn; float ss = 0.f;
#pragma unroll
        for (int k = 0; k < 4; ++k) { const float v = cv[k] * hv[k]; vn[k] = v; y[k] = bv[k] * (w0[k] * s0[k] + w1[k] * s1[k] + w2[k] * v) * silu_f(z[k]); ss += y[k] * y[k]; }
        *(f32x4*)(so + c0) = s1; *(f32x4*)(so + DM + c0) = vn;
        const float tot = block_sum(ss, red); const float rs = __builtin_amdgcn_rsqf(tot * (1.0f / 2048.f) + EPS);
        u32x2 pk; pk.x = cvt_pk_bf16(y[0] * rs, y[1] * rs); pk.y = cvt_pk_bf16(y[2] * rs, y[3] * rs);
        *(u32x2*)(ymix + (size_t)R * KO + 2048 + c0) = pk;
    }
    __syncthreads();
}

__device__ void sc_item(const Params& p, int item) {
    const int tid = threadIdx.x, lane = tid & 63, w = tid >> 6;
    const bf16_t* proj = (const bf16_t*)(p.ws + WS_PROJ);
    bf16_t* ymix = (bf16_t*)(p.ws + WS_YMIX);
    float* ssq2 = (float*)(p.ws + WS_SSQ2);
    const int t0 = item * 64; const int b = t0 >> 11, tpos = t0 & 2047;
    const int pr0 = t0 + NMETA * (b + 1);
    const int c0 = w * 256 + lane * 4;
    const f32x4 w0 = *(const f32x4*)(p.conv_sc_w + c0), w1 = *(const f32x4*)(p.conv_sc_w + DM + c0), w2 = *(const f32x4*)(p.conv_sc_w + 2 * DM + c0);
    f32x4 vm2, vm1;
    {
        const int g2 = pr0 - 2, g1 = pr0 - 1;
        const u32x2 c2 = *(const u32x2*)(proj + (size_t)g2 * NP + CCS + c0), h2 = *(const u32x2*)(proj + (size_t)g2 * NP + CHS + c0);
        const u32x2 c1 = *(const u32x2*)(proj + (size_t)g1 * NP + CCS + c0), h1 = *(const u32x2*)(proj + (size_t)g1 * NP + CHS + c0);
        vm2 = (f32x4){bf_lo(c2.x) * bf_lo(h2.x), bf_hi(c2.x) * bf_hi(h2.x), bf_lo(c2.y) * bf_lo(h2.y), bf_hi(c2.y) * bf_hi(h2.y)};
        vm1 = (f32x4){bf_lo(c1.x) * bf_lo(h1.x), bf_hi(c1.x) * bf_hi(h1.x), bf_lo(c1.y) * bf_lo(h1.y), bf_hi(c1.y) * bf_hi(h1.y)};
    }
    const int b5 = lane >> 5, b4 = (lane >> 4) & 1, b3 = (lane >> 3) & 1;
#define SC_LOAD(Z, B, C, H, i0_) do { _Pragma("unroll") for (int u = 0; u < 8; ++u) { const bf16_t* pr = proj + (size_t)(pr0 + (i0_) + u) * NP + c0; \
            Z[u] = *(const u32x2*)(pr + CZS); B[u] = *(const u32x2*)(pr + CBS); C[u] = *(const u32x2*)(pr + CCS); H[u] = *(const u32x2*)(pr + CHS); } } while (0)
#define SC_PROC(Z, B, C, H, i0_) do { float ssr[8]; \
        _Pragma("unroll") for (int u = 0; u < 8; ++u) { const int t = t0 + (i0_) + u; \
            const f32x4 v = (f32x4){bf_lo(C[u].x) * bf_lo(H[u].x), bf_hi(C[u].x) * bf_hi(H[u].x), bf_lo(C[u].y) * bf_lo(H[u].y), bf_hi(C[u].y) * bf_hi(H[u].y)}; \
            const f32x4 z = (f32x4){bf_lo(Z[u].x), bf_hi(Z[u].x), bf_lo(Z[u].y), bf_hi(Z[u].y)}; \
            const f32x4 bv = (f32x4){bf_lo(B[u].x), bf_hi(B[u].x), bf_lo(B[u].y), bf_hi(B[u].y)}; \
            const f32x4 cv = w0 * vm2 + w1 * vm1 + w2 * v; \
            f32x4 y; float ss = 0.f; \
            _Pragma("unroll") for (int k = 0; k < 4; ++k) { y[k] = bv[k] * cv[k] * silu_f(z[k]); ss += y[k] * y[k]; } \
            ssr[u] = ss; \
            u32x2 pk; pk.x = cvt_pk_bf16(y[0], y[1]); pk.y = cvt_pk_bf16(y[2], y[3]); \
            *(u32x2*)(ymix + (size_t)t * KO + 2048 + c0) = pk; \
            if ((t & 2047) == 2047) { float* so = p.out + O_SCP + (size_t)b * 2 * DM; *(f32x4*)(so + c0) = vm1; *(f32x4*)(so + DM + c0) = v; } \
            vm2 = vm1; vm1 = v; } \
        float s4[4], s2[2]; \
        _Pragma("unroll") for (int k = 0; k < 4; ++k) { const float snd = b5 ? ssr[k] : ssr[4 + k], kp = b5 ? ssr[4 + k] : ssr[k]; s4[k] = kp + __shfl_xor(snd, 32); } \
        _Pragma("unroll") for (int k = 0; k < 2; ++k) { const float snd = b4 ? s4[k] : s4[2 + k], kp = b4 ? s4[2 + k] : s4[k]; s2[k] = kp + __shfl_xor(snd, 16); } \
        float s1; { const float snd = b3 ? s2[0] : s2[1], kp = b3 ? s2[1] : s2[0]; s1 = sum8_dpp(kp + __shfl_xor(snd, 8)); } \
        if ((lane & 7) == 0) unsafeAtomicAdd(ssq2 + t0 + (i0_) + 4 * b5 + 2 * b4 + b3, s1); } while (0)
    u32x2 zA[8], bA[8], cA[8], hA[8], zB[8], bB[8], cB[8], hB[8];
    SC_LOAD(zA, bA, cA, hA, 0);
    for (int i0 = 0; i0 < 64; i0 += 16) {
        SC_LOAD(zB, bB, cB, hB, i0 + 8);
        SC_PROC(zA, bA, cA, hA, i0);
        if (i0 + 16 < 64) SC_LOAD(zA, bA, cA, hA, i0 + 16);
        SC_PROC(zB, bB, cB, hB, i0 + 8);
    }
#undef SC_LOAD
#undef SC_PROC
    if (tpos == 2048 - 64) {
        float* co = p.out + O_CSP + (size_t)b * 3 * DXBC;
        for (int i = tid; i < 3 * DXBC; i += 512) { const int rr = i / DXBC, col = i - rr * DXBC; co[i] = bf1(proj[(size_t)(b * BROWS + NMETA + 2045 + rr) * NP + CX + col]); }
    }
}

__device__ void sample_outproj(const Params& p, LAS unsigned char* lds) {
    const int tid = threadIdx.x, lane = tid & 63, w = tid >> 6;
    const bf16_t* ymix = (const bf16_t*)(p.ws + WS_YMIX); const bf16_t* WoutT = (const bf16_t*)(p.ws + WS_WOUT);
    const int strip = blockIdx.x >> 1, rhalf = blockIdx.x & 1; const int n0 = strip * 16;
    const int rg = w & 3, kh = w >> 2;
    const int fr = lane & 15, fq = lane >> 4;
    const bf16_t* ap = ymix + (size_t)(YROW_S0 + rhalf * 64 + rg * 16 + fr) * KO + kh * 2048 + fq * 8;
    const bf16_t* bp = WoutT + (size_t)(n0 + fr) * KO + kh * 2048 + fq * 8;
    f32x4 acc = (f32x4){0.f, 0.f, 0.f, 0.f};
    for (int ks = 0; ks < 64; ks += 16) {
        bf16x8 a[16], b[16];
#pragma unroll
        for (int u = 0; u < 16; ++u) { a[u] = *(const bf16x8*)(ap + (ks + u) * 32); b[u] = *(const bf16x8*)(bp + (ks + u) * 32); }
#pragma unroll
        for (int u = 0; u < 16; ++u) acc = __builtin_amdgcn_mfma_f32_16x16x32_bf16(a[u], b[u], acc, 0, 0, 0);
    }
    LAS f32x4* ex = (LAS f32x4*)lds;
    if (kh == 1) ex[rg * 64 + lane] = acc;
    __syncthreads();
    if (kh == 0) {
        acc += ex[rg * 64 + lane];
#pragma unroll
        for (int i = 0; i < 4; ++i) { const int srow = rhalf * 64 + rg * 16 + fq * 4 + i; p.out[O_YS + (size_t)srow * DM + n0 + fr] = acc[i]; }
    }
    __syncthreads();
}

__device__ void p4_final(const Params& p) {
    const int tid = threadIdx.x, lane = tid & 63, wid = tid >> 6;
    const int gw = blockIdx.x * 8 + wid, nw = gridDim.x * 8;
    f32x4 fw[8];
#pragma unroll
    for (int i = 0; i < 8; ++i) fw[i] = *(const f32x4*)(p.final_norm_w + i * 256 + lane * 4);
    for (int r = gw; r < 8192 + 128; r += nw) {
        float* o = r < 8192 ? p.out + O_YP + (size_t)r * DM : p.out + O_YS + (size_t)(r - 8192) * DM;
        const float* x = r < 8192 ? p.x_prompt + (size_t)r * DM : p.x_sample + (size_t)(r - 8192) * DM;
        f32x4 v[8]; float ss = 0.f;
#pragma unroll
        for (int i = 0; i < 8; ++i) { const f32x4 a = *(const f32x4*)(o + i * 256 + lane * 4), b = __builtin_nontemporal_load((const f32x4*)(x + i * 256 + lane * 4)); v[i] = a + b;
            ss += (v[i][0] * v[i][0] + v[i][1] * v[i][1]) + (v[i][2] * v[i][2] + v[i][3] * v[i][3]); }
        ss = wave_sum(ss);
        const float rs = __builtin_amdgcn_rsqf(ss * (1.0f / 2048.f) + EPS);
#pragma unroll
        for (int i = 0; i < 8; ++i) __builtin_nontemporal_store(v[i] * rs * fw[i], (f32x4*)(o + i * 256 + lane * 4));
    }
}

#define XB_TMO      128
#define XB_XCNT(j)  (256  + 64 * (j))
#define XB_XSUB(j)  (1280 + 64 * (j))
#define XB_XGEN(j)  (2304 + 64 * (j))
#define XB_TOP      3328
#define XB_TOPGEN   3392
#define XCD_BAR_WORDS 3456
#define XB_SPIN_CAP (1u << 18)
__device__ __forceinline__ unsigned xb_ld(unsigned* p)              { return __hip_atomic_load(p, __ATOMIC_RELAXED, __HIP_MEMORY_SCOPE_AGENT); }
__device__ __forceinline__ unsigned xb_add(unsigned* p, unsigned v) { return __hip_atomic_fetch_add(p, v, __ATOMIC_RELAXED, __HIP_MEMORY_SCOPE_AGENT); }
__device__ __forceinline__ unsigned xb_xcc_id() { return (unsigned)__builtin_amdgcn_s_getreg((3 << 11) | 20) & 0xFu; }
#define XB_SPIN(cond, bar) do { unsigned _sp = 0; while (cond) { __builtin_amdgcn_s_sleep(1); \
    if ((++_sp & 255u) == 0u) { if (xb_ld(&(bar)[XB_TMO])) break; if (_sp > XB_SPIN_CAP) { atomicAdd(&(bar)[XB_TMO], 1u); break; } } } } while (0)
struct XcdBarrier { unsigned* bar; unsigned x; volatile LAS unsigned* st; };
__device__ __forceinline__ XcdBarrier xcd_barrier_post(unsigned* bar, volatile LAS unsigned* st) {
    XcdBarrier b; b.bar = bar; b.x = xb_xcc_id(); b.st = st;
    if (threadIdx.x == 0) (void)xb_add(&bar[XB_XCNT(b.x)], 1u);
    return b;
}
__device__ __forceinline__ void xcd_barrier_complete(unsigned* bar, unsigned x, unsigned& nloc, unsigned& nx) {
    const unsigned G = gridDim.x * gridDim.y * gridDim.z;
    unsigned sum, cnt, mine, sp = 0u;
    for (;;) {
        sum = 0u; cnt = 0u; mine = 0u;
#pragma unroll
        for (unsigned j = 0; j < 16; ++j) { const unsigned c = xb_ld(&bar[XB_XCNT(j)]); sum += c; cnt += (c > 0u) ? 1u : 0u; mine = (j == x) ? c : mine; }
        if (sum == G) break;
        __builtin_amdgcn_s_sleep(1);
        if ((++sp & 255u) == 0u) { if (xb_ld(&bar[XB_TMO])) break; if (sp > XB_SPIN_CAP) { atomicAdd(&bar[XB_TMO], 1u); break; } }
    }
    nloc = mine > 0u ? mine : 1u; nx = cnt > 0u ? cnt : 1u;
}
__device__ __forceinline__ void xcd_barrier(const XcdBarrier& b) {
    asm volatile("s_waitcnt vmcnt(0)" ::: "memory");
    __syncthreads();
    if (threadIdx.x == 0) {
        unsigned* bar = b.bar;
        __builtin_amdgcn_s_waitcnt(0);
        unsigned nloc = b.st[0], nx = b.st[1];
        if (nloc == 0u) { xcd_barrier_complete(bar, b.x, nloc, nx); b.st[0] = nloc; b.st[1] = nx; }
        const unsigned old = xb_add(&bar[XB_XSUB(b.x)], 1u);
        const unsigned gen = old / nloc;
        if (old + 1u == (gen + 1u) * nloc) {
            __builtin_amdgcn_fence(__ATOMIC_RELEASE, "agent");
            asm volatile("s_waitcnt vmcnt(0)" ::: "memory");
            const unsigned og = xb_add(&bar[XB_TOP], 1u);
            const unsigned tg = og / nx;
            if (og + 1u == (tg + 1u) * nx) xb_add(&bar[XB_TOPGEN], 1u);
            else XB_SPIN(xb_ld(&bar[XB_TOPGEN]) == tg, bar);
            __builtin_amdgcn_fence(__ATOMIC_ACQUIRE, "agent");
            xb_add(&bar[XB_XGEN(b.x)], 1u);
            asm volatile("s_waitcnt vmcnt(0)" ::: "memory");
        } else {
            XB_SPIN(xb_ld(&bar[XB_XGEN(b.x)]) == gen, bar);
            __builtin_amdgcn_fence(__ATOMIC_ACQUIRE, "agent");
            asm volatile("s_waitcnt vmcnt(0)" ::: "memory");
        }
    }
    __syncthreads();
}

__global__ void __launch_bounds__(512, 2) hymba_fwd(Params p) {
    extern __shared__ __attribute__((aligned(16))) unsigned char lds_raw[];
    LAS unsigned char* lds = (LAS unsigned char*)lds_raw;
    cg::grid_group grid = cg::this_grid();
    const int lo = p.ph_lo, hi = p.ph_hi;
#ifdef ONLY
#define IN(k) ((k) == ONLY && lo <= (k) && (k) < hi)
#else
#define IN(k) (lo <= (k) && (k) < hi)
#endif
#define SEAM(k) do { if (IN(k) && IN((k) + 1)) xcd_barrier(xb); } while (0)
    unsigned* barw = (unsigned*)(p.ws + WS_BAR);
    if (threadIdx.x < 4) ((volatile LAS unsigned*)(lds + LDS_BYTES - 16))[threadIdx.x] = 0u;
    __syncthreads();
    XcdBarrier xb = xcd_barrier_post(barw, (volatile LAS unsigned*)(lds + LDS_BYTES - 16));
    if (p.flags & 0x40000000) grid.sync();
    if (IN(0)) p0_prep(p, lds);
    SEAM(0);
    if (IN(1)) {
        pg8::Gemm g{(const bf16_t*)(p.ws + WS_HN), (const bf16_t*)(p.ws + WS_WIN), MP, NP, DM};
        pg8::StaticOrder S; S.init(MP, NP, (int)gridDim.x, (int)blockIdx.x);
        pg8::EpiProj E{(bf16_t*)(p.ws + WS_PROJ), NP};
        pg8::gemm_phase<pg8::EpiProj>(lds, g, S, E);
    }
    SEAM(1);
    if (IN(2)) conv_pre(p);
    SEAM(2);
    if (IN(3)) {
        const int it = blockIdx.x;
        if (it < 128) { if (!(p.flags & 8)) ssd_item(p, lds, it); }
        else { if (!(p.flags & 4)) decode_item(p, lds, it - 128); if (!(p.flags & 16)) sc_item(p, it - 128); }
    }
    SEAM(3);
    if (IN(4)) {
        if (!(p.flags & 1)) sample_outproj(p, lds);
        pg8::Gemm g{(const bf16_t*)(p.ws + WS_YMIX), (const bf16_t*)(p.ws + WS_WOUT), 8192, DM, KO};
        pg8::StaticOrder S; S.init(8192, DM, (int)gridDim.x, (int)blockIdx.x);
        LAS float* tab = (LAS float*)(lds + pg8::STAGE_BYTES);
        { pg8::Unit u0; S.next(0, u0);
          if (threadIdx.x < 256) { const int r = u0.pm * 256 + threadIdx.x; const float s1 = ((const float*)(p.ws + WS_SSQ1))[r], s2 = ((const float*)(p.ws + WS_SSQ2))[r];
              const float q1 = s1 * (1.0f / 2048.f) + EPS, q2 = s2 * (1.0f / 2048.f) + EPS;
              tab[threadIdx.x] = __builtin_sqrtf(q2 / q1); tab[256 + threadIdx.x] = __builtin_amdgcn_rsqf(q2); }
          __syncthreads(); }
        pg8::EpiOut E{p.out + O_YP, tab};
        if (!(p.flags & 2)) pg8::gemm_phase<pg8::EpiOut>(lds, g, S, E);
    }
    SEAM(4);
    if (IN(5)) p4_final(p);
#undef IN
#undef SEAM
}

extern "C" void kernel_launch(void* const* d_in, const int* in_sizes, int n_in, void* d_out, int out_size, void* d_ws, size_t ws_size, hipStream_t stream) {
    static int grid = 0;
    if (grid == 0) {
        int dev = 0, cus = 0, per_cu = 0;
        hipGetDevice(&dev); hipDeviceGetAttribute(&cus, hipDeviceAttributeMultiprocessorCount, dev);
        hipFuncSetAttribute((const void*)hymba_fwd, hipFuncAttributeMaxDynamicSharedMemorySize, LDS_BYTES);
        hipOccupancyMaxActiveBlocksPerMultiprocessor(&per_cu, (const void*)hymba_fwd, 512, LDS_BYTES);
        if (per_cu < 1) per_cu = 1;
        grid = cus * 1;
        if (grid > 256) grid = 256;
        if (ws_size < WS_END) { fprintf(stderr, "workspace too small: %zu < %zu\n", ws_size, (size_t)WS_END); }
    }
    (void)hipMemsetAsync((char*)d_ws + WS_BAR, 0, 16384, stream);
    Params p{};
    p.x_prompt = (const float*)d_in[0]; p.x_sample = (const float*)d_in[1]; p.state_ssm = (const float*)d_in[2]; p.state_ssd_conv = (const float*)d_in[3];
    p.state_short_conv = (const float*)d_in[4]; p.meta = (const float*)d_in[5]; p.norm_w = (const float*)d_in[6]; p.w_in = (const float*)d_in[7];
    p.conv_ssd_w = (const float*)d_in[8]; p.conv_ssd_b = (const float*)d_in[9]; p.dt_bias = (const float*)d_in[10]; p.a_log = (const float*)d_in[11];
    p.d_skip = (const float*)d_in[12]; p.ssd_norm_w = (const float*)d_in[13]; p.conv_sc_w = (const float*)d_in[14]; p.sc_norm_w = (const float*)d_in[15];
    p.w_out = (const float*)d_in[16]; p.final_norm_w = (const float*)d_in[17];
    p.out = (float*)d_out; p.ws = (unsigned char*)d_ws;
#if N_LAUNCH == 1
    p.ph_lo = 0; p.ph_hi = 6;
    void* args[] = {&p};
    hipError_t e = hipLaunchCooperativeKernel((const void*)hymba_fwd, dim3(grid), dim3(512), args, LDS_BYTES, stream);
    if (e != hipSuccess) fprintf(stderr, "cooperative launch failed: %s (grid %d)\n", hipGetErrorString(e), grid);
#else
    const int sched[][3] = {SCHED};
    for (unsigned li = 0; li < sizeof(sched) / sizeof(sched[0]); ++li) {
        p.ph_lo = sched[li][0]; p.ph_hi = sched[li][1]; p.flags = sched[li][2];
        void* args[] = {&p};
        hipError_t e = hipLaunchCooperativeKernel((const void*)hymba_fwd, dim3(grid), dim3(512), args, LDS_BYTES, stream);
        if (e != hipSuccess) fprintf(stderr, "cooperative launch failed: %s (grid %d)\n", hipGetErrorString(e), grid);
    }
#endif
}
```
